# Optimizing an MI355X kernel written in HIP

```python
import math, functools
import jax, jax.numpy as jnp
from jax import lax
import numpy as np

D_MODEL = 1024
BATCH = 8
SEQ = 2048
DEPTH = 2

D_FF = 2816
SSD_HEADS = 16
SSD_HEAD_DIM = 64
SSD_D_INNER = SSD_HEADS * SSD_HEAD_DIM
SSD_GROUPS = 2
SSD_STATE = 128
SSD_CONV = 4
SSD_CHUNK = 128
SSD_CONV_DIM = SSD_D_INNER + 2 * SSD_GROUPS * SSD_STATE
MLA_HEADS = 8
MLA_Q_RANK = 384
MLA_KV_RANK = 256
MLA_NOPE = 128
MLA_ROPE = 64
MLA_V = 128
ROPE_THETA = 10000.0
ATTN_BLOCK = 128
SGU_WIDTH = 2 * D_MODEL
SGU_GROUPS = 16
SGU_GROUP_DIM = SGU_WIDTH // SGU_GROUPS
SGU_CHUNK = 128
EVEN_SPLITS = [SSD_D_INNER,
               SSD_D_INNER + SSD_CONV_DIM,
               SSD_D_INNER + SSD_CONV_DIM + SSD_HEADS,
               SSD_D_INNER + SSD_CONV_DIM + SSD_HEADS + MLA_Q_RANK,
               SSD_D_INNER + SSD_CONV_DIM + SSD_HEADS + MLA_Q_RANK + MLA_KV_RANK]
EVEN_IN = EVEN_SPLITS[-1] + MLA_ROPE
EVEN_MIX = SSD_D_INNER + MLA_HEADS * MLA_V
DEEPNORM_ALPHA = (2 * DEPTH) ** 0.25
DEEPNORM_BETA = (8 * DEPTH) ** -0.25
N_MOD = 9
EPS = 1e-5

kernel_name = "conditioned_hybrid_ssd_mla_sgu_trunk"


def layer_norm(x, g, b):
    xf = x.astype(jnp.float32)
    mu = jnp.mean(xf, -1, keepdims=True)
    var = jnp.mean(jnp.square(xf - mu), -1, keepdims=True)
    return ((xf - mu) * lax.rsqrt(var + EPS) * g + b).astype(x.dtype)


def rms_norm(x, w):
    xf = x.astype(jnp.float32)
    return (xf * lax.rsqrt(jnp.mean(xf * xf, -1, keepdims=True) + EPS) * w).astype(x.dtype)


def swiglu(h, w_in, w_out):
    a, b = jnp.split(h @ w_in, 2, axis=-1)
    return (jax.nn.silu(a) * b) @ w_out


def rope_tables(seq):
    inv = 1.0 / (ROPE_THETA ** (jnp.arange(0, MLA_ROPE, 2, dtype=jnp.float32) / MLA_ROPE))
    ang = jnp.arange(seq, dtype=jnp.float32)[:, None] * inv[None, :]
    return jnp.cos(ang), jnp.sin(ang)


def apply_rope(x, cos, sin):
    x1, x2 = jnp.split(x.astype(jnp.float32), 2, axis=-1)
    return jnp.concatenate([x1 * cos - x2 * sin, x2 * cos + x1 * sin], -1).astype(x.dtype)


def causal_depthwise_conv(x, w, bias):
    out = lax.conv_general_dilated(x, w[:, None, :], window_strides=(1,),
                                   padding=[(SSD_CONV - 1, 0)],
                                   dimension_numbers=('NWC', 'WIO', 'NWC'),
                                   feature_group_count=x.shape[-1])
    return out + bias


def segsum_exp(a):
    q = a.shape[-1]
    cs = jnp.cumsum(a, axis=-1)
    diff = cs[..., :, None] - cs[..., None, :]
    mask = jnp.tril(jnp.ones((q, q), dtype=bool))
    return jnp.where(mask, jnp.exp(jnp.where(mask, diff, 0.0)), 0.0)


def ssd_chunked_scan(x, dt, a, bm, cm):
    b, s = x.shape[:2]
    nc = s // SSD_CHUNK
    r = SSD_HEADS // SSD_GROUPS
    xc = (x * dt[..., None]).reshape(b, nc, SSD_CHUNK, SSD_GROUPS, r, SSD_HEAD_DIM)
    adt = (dt * a).reshape(b, nc, SSD_CHUNK, SSD_GROUPS, r).transpose(0, 3, 4, 1, 2)
    bc = bm.reshape(b, nc, SSD_CHUNK, SSD_GROUPS, SSD_STATE)
    cc = cm.reshape(b, nc, SSD_CHUNK, SSD_GROUPS, SSD_STATE)
    a_cs = jnp.cumsum(adt, axis=-1)
    decay = segsum_exp(adt)
    cb = jnp.einsum('bclgn,bcsgn->bgcls', cc, bc)
    y_diag = jnp.einsum('bgrcls,bcsgrp->bclgrp', cb[:, :, None] * decay, xc)
    decay_to_end = jnp.exp(a_cs[..., -1:] - a_cs)
    states = jnp.einsum('bclgn,bgrcl,bclgrp->bcgrpn', bc, decay_to_end, xc)
    chunk_decay = jnp.exp(a_cs[..., -1])

    def step(h, inp):
        s_c, d_c = inp
        return d_c[..., None, None] * h + s_c, h

    h0 = jnp.zeros((b, SSD_GROUPS, r, SSD_HEAD_DIM, SSD_STATE), states.dtype)
    _, prev = lax.scan(step, h0, (states.transpose(1, 0, 2, 3, 4, 5),
                                  chunk_decay.transpose(3, 0, 1, 2)))
    prev = prev.transpose(1, 0, 2, 3, 4, 5)
    y_off = jnp.einsum('bclgn,bcgrpn,bgrcl->bclgrp', cc, prev, jnp.exp(a_cs))
    return (y_diag + y_off).reshape(b, s, SSD_HEADS, SSD_HEAD_DIM)


def mla_attention(cq, ckv, k_rope, q_norm_w, w_uq, kv_norm_w, w_ukv, cos, sin):
    b, s, _ = cq.shape
    q = (rms_norm(cq, q_norm_w) @ w_uq).reshape(b, s, MLA_HEADS, MLA_NOPE + MLA_ROPE)
    q_nope, q_pe = q[..., :MLA_NOPE], q[..., MLA_NOPE:]
    q_pe = apply_rope(q_pe, cos[:, None, :], sin[:, None, :])
    kv = (rms_norm(ckv, kv_norm_w) @ w_ukv).reshape(b, s, MLA_HEADS, MLA_NOPE + MLA_V)
    k_nope, v = kv[..., :MLA_NOPE], kv[..., MLA_NOPE:]
    k_pe = apply_rope(k_rope, cos, sin)
    k = jnp.concatenate([k_nope, jnp.broadcast_to(k_pe[:, :, None, :], (b, s, MLA_HEADS, MLA_ROPE))], -1)
    qh = jnp.concatenate([q_nope, q_pe], -1)
    scale = (MLA_NOPE + MLA_ROPE) ** -0.5
    outs = []
    for i in range(s // ATTN_BLOCK):
        start, end = i * ATTN_BLOCK, (i + 1) * ATTN_BLOCK
        sc = jnp.einsum('bqhd,bkhd->bhqk', qh[:, start:end], k[:, :end]).astype(jnp.float32) * scale
        mask = (start + jnp.arange(ATTN_BLOCK))[:, None] >= jnp.arange(end)[None, :]
        p = jax.nn.softmax(jnp.where(mask, sc, -jnp.inf), axis=-1).astype(v.dtype)
        outs.append(jnp.einsum('bhqk,bkhd->bqhd', p, v[:, :end]))
    return jnp.concatenate(outs, axis=1).reshape(b, s, MLA_HEADS * MLA_V)


def even_mixer(h, w_in, conv_w, conv_b, dt_bias, a_log, d_skip, ssd_norm_w,
               q_norm_w, w_uq, kv_norm_w, w_ukv, w_out, cos, sin):
    b, s, _ = h.shape
    z, xbc, dt_raw, cq, ckv, k_rope = jnp.split(h @ w_in, EVEN_SPLITS, axis=-1)
    xbc = jax.nn.silu(causal_depthwise_conv(xbc, conv_w, conv_b))
    xs, bm, cm = jnp.split(xbc, [SSD_D_INNER, SSD_D_INNER + SSD_GROUPS * SSD_STATE], axis=-1)
    xs4 = xs.reshape(b, s, SSD_HEADS, SSD_HEAD_DIM).astype(jnp.float32)
    dt = jax.nn.softplus(dt_raw.astype(jnp.float32) + dt_bias)
    a = -jnp.exp(a_log.astype(jnp.float32))
    y = ssd_chunked_scan(xs4, dt, a,
                         bm.reshape(b, s, SSD_GROUPS, SSD_STATE).astype(jnp.float32),
                         cm.reshape(b, s, SSD_GROUPS, SSD_STATE).astype(jnp.float32))
    y = (y + d_skip[:, None] * xs4).reshape(b, s, SSD_D_INNER).astype(h.dtype)
    yg = (y * jax.nn.silu(z)).reshape(b, s, SSD_GROUPS, SSD_D_INNER // SSD_GROUPS)
    y_ssd = rms_norm(yg, ssd_norm_w.reshape(SSD_GROUPS, -1)).reshape(b, s, SSD_D_INNER)
    y_att = mla_attention(cq, ckv, k_rope, q_norm_w, w_uq, kv_norm_w, w_ukv, cos, sin)
    return jnp.concatenate([y_ssd, y_att], axis=-1) @ w_out


def odd_mixer(h, w_uv, b_uv, sgu_ln_g, sgu_ln_b, w_s, b_s, w_out):
    b, s, _ = h.shape
    u, v = jnp.split(jax.nn.gelu(h @ w_uv + b_uv, approximate=False), 2, axis=-1)
    v = layer_norm(v, sgu_ln_g, sgu_ln_b)
    vc = v.reshape(b, s // SGU_CHUNK, SGU_CHUNK, SGU_GROUPS, SGU_GROUP_DIM)
    w_causal = w_s * jnp.tril(jnp.ones((SGU_CHUNK, SGU_CHUNK), w_s.dtype))
    sp = jnp.einsum('gts,bcsgd->bctgd', w_causal, vc) + b_s.T[None, None, :, :, None]
    return (u * sp.reshape(b, s, SGU_WIDTH)) @ w_out


def hybrid_layer(x, c, ada_w, ada_b, ln_g, ln_b, ffa_w_in, ffa_w_out, ffb_w_in, ffb_w_out, mixer):
    mod = jax.nn.silu(c) @ ada_w + ada_b
    sh1, sc1, g1, sh2, sc2, g2, sh3, sc3, g3 = [m[:, None, :] for m in jnp.split(mod, N_MOD, axis=-1)]
    f1 = 0.5 * swiglu(x * (1.0 + sc1) + sh1, ffa_w_in, ffa_w_out)
    x = layer_norm(DEEPNORM_ALPHA * x + (1.0 + g1) * f1, ln_g[0], ln_b[0])
    m = mixer(x * (1.0 + sc2) + sh2)
    x = layer_norm(DEEPNORM_ALPHA * x + (1.0 + g2) * m, ln_g[1], ln_b[1])
    f2 = 0.5 * swiglu(x * (1.0 + sc3) + sh3, ffb_w_in, ffb_w_out)
    return layer_norm(DEEPNORM_ALPHA * x + (1.0 + g3) * f2, ln_g[2], ln_b[2])


def setup_inputs(seed: int = 0) -> dict:
    key = jax.random.key(seed)
    keys = iter(jax.random.split(key, 64))
    f32 = jnp.float32

    def nrm(shape, scale):
        return jax.random.normal(next(keys), shape, f32) * scale

    def gain(shape):
        return 1.0 + nrm(shape, 0.02)

    def common(prefix):
        return {
            prefix + 'ada_w': nrm((D_MODEL, N_MOD * D_MODEL), 0.2 * D_MODEL ** -0.5),
            prefix + 'ada_b': nrm((N_MOD * D_MODEL,), 0.01),
            prefix + 'ln_g': gain((3, D_MODEL)),
            prefix + 'ln_b': nrm((3, D_MODEL), 0.01),
            prefix + 'ffa_w_in': nrm((D_MODEL, 2 * D_FF), D_MODEL ** -0.5),
            prefix + 'ffa_w_out': nrm((D_FF, D_MODEL), D_FF ** -0.5 * DEEPNORM_BETA),
            prefix + 'ffb_w_in': nrm((D_MODEL, 2 * D_FF), D_MODEL ** -0.5),
            prefix + 'ffb_w_out': nrm((D_FF, D_MODEL), D_FF ** -0.5 * DEEPNORM_BETA),
        }

    out = {'x': nrm((BATCH, SEQ, D_MODEL), 1.0), 'c': nrm((BATCH, D_MODEL), 1.0)}
    out.update(common('l0_'))
    dt0 = jnp.exp(jax.random.uniform(next(keys), (SSD_HEADS,), f32)
                  * (math.log(0.1) - math.log(0.001)) + math.log(0.001))
    out.update({
        'l0_w_in': nrm((D_MODEL, EVEN_IN), D_MODEL ** -0.5),
        'l0_conv_w': nrm((SSD_CONV, SSD_CONV_DIM), SSD_CONV ** -0.5),
        'l0_conv_b': nrm((SSD_CONV_DIM,), 0.01),
        'l0_dt_bias': dt0 + jnp.log(-jnp.expm1(-dt0)),
        'l0_a_log': jnp.log(jax.random.uniform(next(keys), (SSD_HEADS,), f32, 1.0, 16.0)),
        'l0_d_skip': 1.0 + nrm((SSD_HEADS,), 0.1),
        'l0_ssd_norm_w': gain((SSD_D_INNER,)),
        'l0_q_norm_w': gain((MLA_Q_RANK,)),
        'l0_w_uq': nrm((MLA_Q_RANK, MLA_HEADS * (MLA_NOPE + MLA_ROPE)), MLA_Q_RANK ** -0.5),
        'l0_kv_norm_w': gain((MLA_KV_RANK,)),
        'l0_w_ukv': nrm((MLA_KV_RANK, MLA_HEADS * (MLA_NOPE + MLA_V)), MLA_KV_RANK ** -0.5),
        'l0_w_out': nrm((EVEN_MIX, D_MODEL), EVEN_MIX ** -0.5 * DEEPNORM_BETA),
    })
    out.update(common('l1_'))
    out.update({
        'l1_w_uv': nrm((D_MODEL, 2 * SGU_WIDTH), D_MODEL ** -0.5),
        'l1_b_uv': nrm((2 * SGU_WIDTH,), 0.01),
        'l1_sgu_ln_g': gain((SGU_WIDTH,)),
        'l1_sgu_ln_b': nrm((SGU_WIDTH,), 0.01),
        'l1_w_s': nrm((SGU_GROUPS, SGU_CHUNK, SGU_CHUNK), SGU_CHUNK ** -0.5),
        'l1_b_s': 1.0 + nrm((SGU_GROUPS, SGU_CHUNK), 0.1),
        'l1_w_out': nrm((SGU_WIDTH, D_MODEL), SGU_WIDTH ** -0.5 * DEEPNORM_BETA),
    })
    return out


def reference(x, c, l0_ada_w, l0_ada_b, l0_ln_g, l0_ln_b, l0_ffa_w_in, l0_ffa_w_out,
              l0_ffb_w_in, l0_ffb_w_out, l0_w_in, l0_conv_w, l0_conv_b, l0_dt_bias,
              l0_a_log, l0_d_skip, l0_ssd_norm_w, l0_q_norm_w, l0_w_uq, l0_kv_norm_w,
              l0_w_ukv, l0_w_out, l1_ada_w, l1_ada_b, l1_ln_g, l1_ln_b, l1_ffa_w_in,
              l1_ffa_w_out, l1_ffb_w_in, l1_ffb_w_out, l1_w_uv, l1_b_uv, l1_sgu_ln_g,
              l1_sgu_ln_b, l1_w_s, l1_b_s, l1_w_out):
    cos, sin = rope_tables(x.shape[1])
    commons = [
        (l0_ada_w, l0_ada_b, l0_ln_g, l0_ln_b, l0_ffa_w_in, l0_ffa_w_out, l0_ffb_w_in, l0_ffb_w_out),
        (l1_ada_w, l1_ada_b, l1_ln_g, l1_ln_b, l1_ffa_w_in, l1_ffa_w_out, l1_ffb_w_in, l1_ffb_w_out),
    ]
    mixers = [
        functools.partial(even_mixer, w_in=l0_w_in, conv_w=l0_conv_w, conv_b=l0_conv_b,
                          dt_bias=l0_dt_bias, a_log=l0_a_log, d_skip=l0_d_skip,
                          ssd_norm_w=l0_ssd_norm_w, q_norm_w=l0_q_norm_w, w_uq=l0_w_uq,
                          kv_norm_w=l0_kv_norm_w, w_ukv=l0_w_ukv, w_out=l0_w_out,
                          cos=cos, sin=sin),
        functools.partial(odd_mixer, w_uv=l1_w_uv, b_uv=l1_b_uv, sgu_ln_g=l1_sgu_ln_g,
                          sgu_ln_b=l1_sgu_ln_b, w_s=l1_w_s, b_s=l1_b_s, w_out=l1_w_out),
    ]
    for layer in range(DEPTH):
        x = hybrid_layer(x, c, *commons[layer], mixers[layer])
    return x
```

```cpp
#include <hip/hip_runtime.h>
#include <hip/hip_cooperative_groups.h>
#include <cstdio>
#include <cstdint>
namespace cg = cooperative_groups;

#define DI __device__ __forceinline__
#define LAS __attribute__((address_space(3)))
typedef unsigned short bf16_t;
typedef short bf16x8 __attribute__((ext_vector_type(8)));
typedef float f32x4 __attribute__((ext_vector_type(4)));
typedef float f32x2 __attribute__((ext_vector_type(2)));
typedef float f32x16 __attribute__((ext_vector_type(16)));
typedef unsigned u32x4 __attribute__((ext_vector_type(4)));
typedef unsigned u32x2 __attribute__((ext_vector_type(2)));

#ifndef MK_MULTI
#define MK_MULTI 0
#endif

constexpr int DM = 1024, NB = 8, SEQ = 2048, MT = NB * SEQ, DFF = 2816;
constexpr float LN_EPS = 1e-5f;
constexpr float DN_ALPHA = 1.41421356237f;
constexpr float QSCALE = 0.07216878364870322f * 1.4426950408889634f;

constexpr size_t MiB = 1u << 20;
constexpr size_t WS_CTL = 0, WS_MUR = MiB / 8, WS_MODS = MiB / 4, WS_ROPEC = 1 * MiB, WS_ROPES = MiB + MiB / 4, WS_PST = 2 * MiB;
constexpr size_t WS_FFIN = 4 * MiB, WS_FFOUT = 15 * MiB;
constexpr size_t WS_WIN = 21 * MiB, WS_WUQ = 27 * MiB + MiB / 2, WS_WUK = 28 * MiB + 3 * MiB / 4, WS_WUV0 = 29 * MiB + MiB / 4, WS_WOUT0 = 30 * MiB;
constexpr size_t WS_WUV1 = 21 * MiB, WS_WOUT1 = 29 * MiB, WS_WSB = 33 * MiB;
constexpr size_t WS_ZA = 34 * MiB, WS_HMOD = 98 * MiB, WS_R = 130 * MiB;
constexpr size_t WS_ACT = WS_R;
constexpr size_t WS_ZG = WS_R, WS_XT = WS_R + 32 * MiB, WS_BT = WS_R + 64 * MiB, WS_BN = WS_R + 72 * MiB, WS_CN = WS_R + 80 * MiB, WS_DT = WS_R + 88 * MiB, WS_CS = WS_R + 89 * MiB,
                 WS_CKVN = WS_R + 90 * MiB, WS_PROJ2 = WS_R + 98 * MiB, WS_YCAT = WS_R + 90 * MiB, WS_KN = WS_R + 154 * MiB;
constexpr size_t WS_VT = WS_HMOD;
constexpr size_t WS_UV = WS_R, WS_VST = WS_R + 128 * MiB;
constexpr size_t WS_END = 316 * MiB;
constexpr size_t DO_Q = 0, DO_CQN = 48 * MiB, DO_KPE = 60 * MiB, DO_SSQ = 62 * MiB;
constexpr int LDS_BYTES = 147456;

DI unsigned pk2(float lo, float hi) { typedef __bf16 b2 __attribute__((ext_vector_type(2))); f32x2 v = {lo, hi}; b2 b = __builtin_convertvector(v, b2); return __builtin_bit_cast(unsigned, b); }
DI float bflo(unsigned u) { return __uint_as_float(u << 16); }
DI float bfhi(unsigned u) { return __uint_as_float(u & 0xffff0000u); }
DI float bf1(bf16_t b) { return __uint_as_float(((unsigned)b) << 16); }
DI bf16_t tobf(float f) { return (bf16_t)(pk2(f, 0.f) & 0xffffu); }
DI float silu_f(float a) { return a * __builtin_amdgcn_rcpf(1.f + __expf(-a)); }
DI float shx(float v, int o, int lane) { return __builtin_bit_cast(float, __builtin_amdgcn_ds_bpermute((lane ^ o) << 2, __builtin_bit_cast(int, v))); }
DI float rdl(float v, int l) { return __builtin_bit_cast(float, __builtin_amdgcn_readlane(__builtin_bit_cast(int, v), l)); }
DI float wave_sum(float v, int lane) {
#pragma unroll
    for (int o = 1; o < 64; o <<= 1) v += shx(v, o, lane);
    return v;
}
DI f32x16 mfma32(bf16x8 a, bf16x8 b, f32x16 c) { return __builtin_amdgcn_mfma_f32_32x32x16_bf16(a, b, c, 0, 0, 0); }
DI int crow(int i, int hh) { return (i & 3) + 8 * (i >> 2) + 4 * hh; }
DI f32x16 zero16() { f32x16 z; for (int i = 0; i < 16; ++i) z[i] = 0.f; return z; }

namespace pg8 {
constexpr int BM = 256, BK = 64, HALF = 128, HTB = HALF * BK * 2, STAGE_BYTES = 8 * HTB, NXCD = 8, WGM = 8;
__host__ __device__ __forceinline__ int lds_byte(int r, int c) { const int st = (r >> 4) * 2 + (c >> 5), rr = r & 15, cc = c & 31, ob = rr * 64 + cc * 2; return st * 1024 + (ob ^ (((ob >> 9) & 1) << 5)); }
__host__ __device__ __forceinline__ void stage_rc(int b, int& R, int& C) { const int st = b / 1024, sb = b % 1024, swz = sb ^ (((sb >> 9) & 1) << 5); R = (st >> 1) * 16 + swz / 64; C = (st & 1) * 32 + (swz % 64) / 2; }
__host__ __device__ __forceinline__ int perm32(int rho) { const int n = rho >> 4, i = rho & 15; return 8 * (i >> 2) + 4 * n + (i & 3); }
struct Unit { int pm, pn; };
struct Gemm { const bf16_t* A; const bf16_t* Bt; int M, N, K, lda, ldb; };
struct StaticOrder {
    int nM, nN, nwg, G, c;
    __host__ __device__ void init(int M, int N, int G_, int c_) { nM = M / BM; nN = N / BM; nwg = nM * nN; G = G_; c = c_; }
    __host__ __device__ bool next(int i, Unit& u) const {
        const long L = (long)i * G + c; if (L >= nwg) return false;
        int wgid = (int)L; { const int q = nwg / NXCD, r = nwg % NXCD, xcd = wgid % NXCD, off = wgid / NXCD; wgid = (xcd < r ? xcd * (q + 1) : r * (q + 1) + (xcd - r) * q) + off; }
        const int nig = WGM * nN, gid = wgid / nig, fm = gid * WGM, gsz = (nM - fm) < WGM ? (nM - fm) : WGM;
        u.pm = fm + ((wgid % nig) % gsz); u.pn = (wgid % nig) / gsz; return true;
    }
};
template <class Epi>
__device__ __forceinline__ void gemm_phase(LAS unsigned char* lds, const Gemm g, const StaticOrder& S, const Epi& E) {
    int tid = threadIdx.x; asm volatile("" : "+v"(tid));
    const int wid = __builtin_amdgcn_readfirstlane(tid >> 6), lane = tid & 63, wr = wid >> 2, wc = wid & 3, fr = lane & 15, fq = lane >> 4;
    const int K = g.K, nt = K / BK;
    unsigned voffA[2], voffB[2];
#pragma unroll
    for (int i = 0; i < 2; ++i) { int R, C; stage_rc(tid * 16 + i * 8192, R, C); const int Rb = Epi::PERM ? ((R & ~31) + perm32(R & 31)) : R;
        voffA[i] = (unsigned)(R * g.lda + C) * 2u; voffB[i] = (unsigned)(Rb * g.ldb + C) * 2u; }
    const size_t kstep = (size_t)(BK * 2);
    const size_t hstepA = (size_t)HALF * g.lda * 2, hstepB = (size_t)HALF * g.ldb * 2;
    const size_t tstepA = 2 * hstepA, tstepB = 2 * hstepB;
    const unsigned ldsw = (unsigned)wid * 1024u;
    const int aoff = lds_byte(wr * 64 + fr, fq * 8), boff = lds_byte(wc * 32 + fr, fq * 8);
#define PG8_SA(b, h) (((b) * 2 + (h)) * HTB)
#define PG8_SB(b, h) ((4 + (b) * 2 + (h)) * HTB)
#define PG8_STAGE(bufoff, gbase, voff) do { _Pragma("unroll") for (int _i = 0; _i < 2; ++_i) \
        __builtin_amdgcn_global_load_lds((const unsigned*)((const char*)(gbase) + (voff)[_i]), (LAS unsigned*)(lds + (bufoff) + ldsw + _i * 8192), 16, 0, 0); } while (0)
#define PG8_LDA(dst, b, h) do { _Pragma("unroll") for (int m = 0; m < 4; ++m) _Pragma("unroll") for (int k = 0; k < 2; ++k) dst[m][k] = *(const LAS bf16x8*)(lds + PG8_SA(b, h) + aoff + m * 2048 + k * 1024); } while (0)
#define PG8_LDB(dst, b, h) do { _Pragma("unroll") for (int n = 0; n < 2; ++n) _Pragma("unroll") for (int k = 0; k < 2; ++k) dst[n][k] = *(const LAS bf16x8*)(lds + PG8_SB(b, h) + boff + n * 2048 + k * 1024); } while (0)
#define PG8_MMA(ai, bj, At, Bt) do { __builtin_amdgcn_s_setprio(1); _Pragma("unroll") for (int m = 0; m < 4; ++m) _Pragma("unroll") for (int n = 0; n < 2; ++n) _Pragma("unroll") for (int k = 0; k < 2; ++k) \
        acc[ai][bj][m][n] = __builtin_amdgcn_mfma_f32_16x16x32_bf16(Bt[n][k], At[m][k], acc[ai][bj][m][n], 0, 0, 0); __builtin_amdgcn_s_setprio(0); } while (0)
#define PG8_WAIT_V(n) asm volatile("s_waitcnt vmcnt(" #n ")" ::: "memory")
#define PG8_WAIT_L(n) asm volatile("s_waitcnt lgkmcnt(" #n ")" ::: "memory")
#define PG8_BAR __builtin_amdgcn_s_barrier()
#define PG8_SCHED __builtin_amdgcn_sched_barrier(0)
    Unit cur, nxt; int ui = 0;
    if (!S.next(0, cur)) return;
    f32x4 acc[2][2][4][2];
#pragma unroll
    for (int a = 0; a < 2; ++a)
#pragma unroll
        for (int b = 0; b < 2; ++b)
#pragma unroll
            for (int m = 0; m < 4; ++m)
#pragma unroll
                for (int n = 0; n < 2; ++n) acc[a][b][m][n] = (f32x4){0.f, 0.f, 0.f, 0.f};
    bf16x8 At[4][2], B0[2][2], B1[2][2];
    const char* cA = (const char*)g.A + (size_t)cur.pm * tstepA; const char* cB = (const char*)g.Bt + (size_t)cur.pn * tstepB;
    PG8_STAGE(PG8_SB(0, 0), cB, voffB); PG8_STAGE(PG8_SB(0, 1), cB + hstepB, voffB); PG8_STAGE(PG8_SA(0, 0), cA, voffA); PG8_STAGE(PG8_SA(0, 1), cA + hstepA, voffA);
    if (wr == 1) PG8_BAR;
    PG8_WAIT_V(2); PG8_BAR;
    PG8_STAGE(PG8_SB(1, 0), cB + kstep, voffB); PG8_STAGE(PG8_SA(1, 0), cA + kstep, voffA); PG8_STAGE(PG8_SB(1, 1), cB + hstepB + kstep, voffB);
    PG8_WAIT_V(6); PG8_BAR;
    for (;;) {
        const bool has_next = S.next(ui + 1, nxt);
        const char* nA = has_next ? (const char*)g.A + (size_t)nxt.pm * tstepA : cA; const char* nB = has_next ? (const char*)g.Bt + (size_t)nxt.pn * tstepB : cB;
#pragma unroll 1
        for (int t = 0; t < nt; t += 2) {
            const bool last = (t == nt - 2);
            const char* a1 = cA + (size_t)(t + 1) * kstep;
            const char* a2 = last ? nA : cA + (size_t)(t + 2) * kstep; const char* b2 = last ? nB : cB + (size_t)(t + 2) * kstep;
            const char* a3 = a2 + kstep; const char* b3 = b2 + kstep;
            PG8_LDB(B0, 0, 0); PG8_LDB(B1, 0, 1); PG8_SCHED; PG8_LDA(At, 0, 0); PG8_STAGE(PG8_SA(1, 1), a1 + hstepA, voffA);
            PG8_WAIT_V(8); PG8_WAIT_L(0); PG8_BAR; PG8_MMA(0, 0, At, B0); PG8_MMA(0, 1, At, B1); PG8_BAR; PG8_SCHED;
            PG8_LDA(At, 0, 1); PG8_STAGE(PG8_SB(0, 0), b2, voffB); PG8_STAGE(PG8_SB(0, 1), b2 + hstepB, voffB); PG8_STAGE(PG8_SA(0, 0), a2, voffA);
            PG8_WAIT_V(8); PG8_WAIT_L(0); PG8_BAR; PG8_MMA(1, 0, At, B0); PG8_MMA(1, 1, At, B1); PG8_BAR; PG8_SCHED;
            PG8_LDB(B0, 1, 0); PG8_LDB(B1, 1, 1); PG8_SCHED; PG8_LDA(At, 1, 0); PG8_STAGE(PG8_SA(0, 1), a2 + hstepA, voffA);
            PG8_WAIT_V(8); PG8_WAIT_L(0); PG8_BAR; PG8_MMA(0, 0, At, B0); PG8_MMA(0, 1, At, B1); PG8_BAR; PG8_SCHED;
            PG8_LDA(At, 1, 1); PG8_STAGE(PG8_SB(1, 0), b3, voffB); PG8_STAGE(PG8_SB(1, 1), b3 + hstepB, voffB); PG8_STAGE(PG8_SA(1, 0), a3, voffA);
            PG8_WAIT_V(8); PG8_WAIT_L(0); PG8_BAR; PG8_MMA(1, 0, At, B0); PG8_MMA(1, 1, At, B1); PG8_BAR; PG8_SCHED;
        }
        if (wr == 0) PG8_BAR;
        { int fr2 = fr, fq2 = fq; asm volatile("" : "+v"(fr2), "+v"(fq2)); E(acc, cur, wr, wc, fr2, fq2); }
        if (!has_next) break;
#pragma unroll
        for (int a = 0; a < 2; ++a)
#pragma unroll
            for (int b = 0; b < 2; ++b)
#pragma unroll
                for (int m = 0; m < 4; ++m)
#pragma unroll
                    for (int n = 0; n < 2; ++n) acc[a][b][m][n] = (f32x4){0.f, 0.f, 0.f, 0.f};
        cur = nxt; cA = nA; cB = nB; ++ui;
        if (wr == 1) PG8_BAR;
    }
    PG8_WAIT_V(0);
    PG8_BAR;
#undef PG8_SA
#undef PG8_SB
#undef PG8_STAGE
#undef PG8_LDA
#undef PG8_LDB
#undef PG8_MMA
#undef PG8_WAIT_V
#undef PG8_WAIT_L
#undef PG8_BAR
#undef PG8_SCHED
}

DI f32x2 gelu_pk(f32x2 v) {
    const f32x2 av = __builtin_elementwise_abs(v), d = av * 0.2316418882f + 1.0f;
    f32x2 t; t.x = __builtin_amdgcn_rcpf(d.x); t.y = __builtin_amdgcn_rcpf(d.y);
    f32x2 q = t * 0.5307027145f + (-0.7265760135f); q = q * t + 0.7107068705f; q = q * t + (-0.142248368f); q = q * t + 0.127414796f; q = q * t;
    const f32x2 s = (v * v) * (-0.72134752044f);
    f32x2 e; e.x = __builtin_amdgcn_exp2f(s.x); e.y = __builtin_amdgcn_exp2f(s.y);
    const f32x2 m = v * (q * e), r = v - m;
    f32x2 o; o.x = v.x < 0.f ? m.x : r.x; o.y = v.y < 0.f ? m.y : r.y; return o;
}
struct EpiBf16 {
    static constexpr bool PERM = true;
    bf16_t* O1; int ld1; bf16_t* O2; int ld2; int split_pn;
    DI void operator()(const f32x4 (&acc)[2][2][4][2], const Unit& u, int wr, int wc, int fr, int fq) const {
        const int row0 = u.pm * BM + wr * 64 + fr;
        bf16_t* base; int ld, colt;
        if (u.pn < split_pn) { base = O1; ld = ld1; colt = u.pn * BM; } else { base = O2; ld = ld2; colt = (u.pn - split_pn) * BM; }
        const int col0 = colt + wc * 32 + 8 * fq;
#pragma unroll
        for (int ai = 0; ai < 2; ++ai)
#pragma unroll
            for (int m = 0; m < 4; ++m) { bf16_t* rowp = base + (size_t)(row0 + ai * HALF + m * 16) * ld + col0;
#pragma unroll
                for (int bj = 0; bj < 2; ++bj) { const f32x4 v0 = acc[ai][bj][m][0], v1 = acc[ai][bj][m][1];
                    u32x4 w; w.x = pk2(v0[0], v0[1]); w.y = pk2(v0[2], v0[3]); w.z = pk2(v1[0], v1[1]); w.w = pk2(v1[2], v1[3]);
                    *(u32x4*)(rowp + bj * HALF) = w; } }
    }
};
struct EpiSwiGLU {
    static constexpr bool PERM = true;
    bf16_t* O; int ldc;
    DI void operator()(const f32x4 (&acc)[2][2][4][2], const Unit& u, int wr, int wc, int fr, int fq) const {
        const int row0 = u.pm * BM + wr * 64 + fr, col0 = u.pn * HALF + wc * 32 + 8 * fq;
#pragma unroll
        for (int ai = 0; ai < 2; ++ai)
#pragma unroll
            for (int m = 0; m < 4; ++m) { bf16_t* rowp = O + (size_t)(row0 + ai * HALF + m * 16) * ldc + col0;
                float o[8];
#pragma unroll
                for (int n = 0; n < 2; ++n)
#pragma unroll
                    for (int j = 0; j < 4; ++j) o[n * 4 + j] = silu_f(acc[ai][0][m][n][j]) * acc[ai][1][m][n][j];
                u32x4 w; w.x = pk2(o[0], o[1]); w.y = pk2(o[2], o[3]); w.z = pk2(o[4], o[5]); w.w = pk2(o[6], o[7]);
                *(u32x4*)rowp = w; }
    }
};
template <bool HALFS> struct EpiResid {
    static constexpr bool PERM = false; static constexpr float scale = HALFS ? 0.5f : 1.0f;
    const float* zprev; const float* mur; const float* lng; const float* lnb;
    const float* gate;
    float* zout; float* pst;
    DI void operator()(const f32x4 (&acc)[2][2][4][2], const Unit& u, int wr, int wc, int fr, int fq) const {
        const int row0 = u.pm * BM + wr * 64 + fr, col0 = u.pn * BM + wc * 32 + 4 * fq, lane = fr | (fq << 4);
        const float* gt = gate + (size_t)((u.pm * BM) / SEQ) * 9216;
#pragma unroll
        for (int ai = 0; ai < 2; ++ai)
#pragma unroll
            for (int m = 0; m < 4; ++m) { const int row = row0 + ai * HALF + m * 16; const size_t off = (size_t)row * DM + col0;
                float mu = 0.f, rs = 1.f; if (mur) { const f32x2 mr = *(const f32x2*)(mur + 2 * row); mu = mr.x; rs = mr.y; }
                float s = 0.f, q = 0.f;
#pragma unroll
                for (int bj = 0; bj < 2; ++bj)
#pragma unroll
                    for (int n = 0; n < 2; ++n) { const int co = bj * HALF + n * 16;
                        f32x4 xr = *(const f32x4*)(zprev + off + co);
                        if (mur) { const f32x4 g4 = *(const f32x4*)(lng + col0 + co), b4 = *(const f32x4*)(lnb + col0 + co); xr = (xr - mu) * rs * g4 + b4; }
                        const f32x4 g1 = *(const f32x4*)(gt + col0 + co);
                        const f32x4 z = xr * DN_ALPHA + (g1 + 1.0f) * (acc[ai][bj][m][n] * scale);
                        *(f32x4*)(zout + off + co) = z;
                        s += (z[0] + z[1]) + (z[2] + z[3]); q += (z[0] * z[0] + z[1] * z[1]) + (z[2] * z[2] + z[3] * z[3]); }
                s += shx(s, 16, lane); s += shx(s, 32, lane); q += shx(q, 16, lane); q += shx(q, 32, lane);
                if (fq == 0) *(f32x2*)(pst + (size_t)row * 32 + (u.pn * 4 + wc) * 2) = (f32x2){s, q};
                asm volatile("" ::: "memory"); }
    }
};
struct EpiQRope {
    static constexpr bool PERM = true;
    bf16_t* Q; const float* rc; const float* rs;
    DI void operator()(const f32x4 (&acc)[2][2][4][2], const Unit& u, int wr, int wc, int fr, int fq) const {
        const int row0 = u.pm * BM + wr * 64 + fr;
        if (u.pn < 4) {
#pragma unroll
            for (int ai = 0; ai < 2; ++ai)
#pragma unroll
                for (int m = 0; m < 4; ++m) { bf16_t* rowp = Q + (size_t)(row0 + ai * HALF + m * 16) * 1536 + wc * 32 + 8 * fq;
#pragma unroll
                    for (int bj = 0; bj < 2; ++bj) { const f32x4 v0 = acc[ai][bj][m][0] * QSCALE, v1 = acc[ai][bj][m][1] * QSCALE;
                        u32x4 w; w.x = pk2(v0[0], v0[1]); w.y = pk2(v0[2], v0[3]); w.z = pk2(v1[0], v1[1]); w.w = pk2(v1[2], v1[3]);
                        *(u32x4*)(rowp + (2 * u.pn + bj) * 192) = w; } }
        } else {
            const int head = 4 * (u.pn - 4) + wc;
#pragma unroll
            for (int ai = 0; ai < 2; ++ai)
#pragma unroll
                for (int m = 0; m < 4; ++m) { const int row = row0 + ai * HALF + m * 16; const int pos = row & (SEQ - 1);
                    bf16_t* rowp = Q + (size_t)row * 1536 + head * 192 + 128 + 8 * fq;
#pragma unroll
                    for (int n = 0; n < 2; ++n) { const f32x4 c4 = *(const f32x4*)(rc + pos * 32 + 8 * fq + 4 * n), s4 = *(const f32x4*)(rs + pos * 32 + 8 * fq + 4 * n);
                        const f32x4 x1 = acc[ai][0][m][n], x2 = acc[ai][1][m][n];
                        const f32x4 a = (x1 * c4 - x2 * s4) * QSCALE, b = (x2 * c4 + x1 * s4) * QSCALE;
                        *(u32x2*)(rowp + 4 * n) = (u32x2){pk2(a[0], a[1]), pk2(a[2], a[3])};
                        *(u32x2*)(rowp + 32 + 4 * n) = (u32x2){pk2(b[0], b[1]), pk2(b[2], b[3])}; }
                    asm volatile("" ::: "memory"); }
        }
    }
};
struct EpiGeluUV {
    static constexpr bool PERM = true;
    bf16_t* O; const float* bias; float* vst;
    DI void operator()(const f32x4 (&acc)[2][2][4][2], const Unit& u, int wr, int wc, int fr, int fq) const {
        const int row0 = u.pm * BM + wr * 64 + fr, col0 = u.pn * BM + wc * 32 + 8 * fq, lane = fr | (fq << 4);
#pragma unroll
        for (int ai = 0; ai < 2; ++ai)
#pragma unroll
            for (int m = 0; m < 4; ++m) { const int row = row0 + ai * HALF + m * 16; bf16_t* rowp = O + (size_t)row * 4096 + col0;
                float s = 0.f, q = 0.f;
#pragma unroll
                for (int bj = 0; bj < 2; ++bj) {
                    const f32x4 b0 = *(const f32x4*)(bias + col0 + bj * HALF), b1 = *(const f32x4*)(bias + col0 + bj * HALF + 4);
                    const f32x4 v0 = acc[ai][bj][m][0] + b0, v1 = acc[ai][bj][m][1] + b1;
                    const f32x2 a = gelu_pk((f32x2){v0[0], v0[1]}), b = gelu_pk((f32x2){v0[2], v0[3]}), c = gelu_pk((f32x2){v1[0], v1[1]}), d = gelu_pk((f32x2){v1[2], v1[3]});
                    u32x4 w; w.x = pk2(a.x, a.y); w.y = pk2(b.x, b.y); w.z = pk2(c.x, c.y); w.w = pk2(d.x, d.y);
                    *(u32x4*)(rowp + bj * HALF) = w;
                    s += (a.x + a.y) + (b.x + b.y) + (c.x + c.y) + (d.x + d.y);
                    q += (a.x * a.x + a.y * a.y) + (b.x * b.x + b.y * b.y) + (c.x * c.x + c.y * c.y) + (d.x * d.x + d.y * d.y); }
                if (u.pn >= 8) { s += shx(s, 16, lane); s += shx(s, 32, lane); q += shx(q, 16, lane); q += shx(q, 32, lane);
                    if (fq == 0) *(f32x2*)(vst + (size_t)row * 64 + ((u.pn - 8) * 4 + wc) * 2) = (f32x2){s, q}; }
                asm volatile("" ::: "memory"); }
    }
};
}

DI int cvt_src(int mode, int nb) {
    if (mode == 1) { return ((nb >> 2) & 1) * DFF + 128 * (nb >> 3) + 32 * (nb & 3); }
    if (mode == 2) { const int t = nb >> 3, half = (nb >> 2) & 1, q = nb & 3;
        return t < 4 ? (2 * t + half) * 192 + 32 * q : (4 * (t - 4) + q) * 192 + 128 + 32 * half; }
    if (mode == 3) { return (nb >> 2) * 256 + 32 * (nb & 3); }
    if (mode == 4) { return (nb >> 2) * 256 + 128 + 32 * (nb & 3); }
    return 32 * nb;
}
DI void cvt_job(const float* W, int K, int N, bf16_t* Wt, int Nout, int mode, LAS float* scr, int gw, int ngw, int lane) {
    const int nblk = Nout / 32, nitems = (K / 64) * nblk;
    for (int it = gw; it < nitems; it += ngw) {
        const int kb = it / nblk, nb = it % nblk, k0 = 64 * kb, n0 = 32 * nb;
        const int sc = cvt_src(mode, nb) + (lane & 31); const bool ok = sc < N;
#pragma unroll 8
        for (int i = 0; i < 32; ++i) { const int kk = 2 * i + (lane >> 5); scr[kk * 33 + (lane & 31)] = ok ? W[(size_t)(k0 + kk) * N + sc] : 0.f; }
        asm volatile("s_waitcnt lgkmcnt(0)" ::: "memory");
        const int c = lane & 7;
#pragma unroll
        for (int j = 0; j < 4; ++j) { const int n = (lane >> 3) + 8 * j; const LAS float* s = scr + (8 * c) * 33 + n;
            u32x4 o; o.x = pk2(s[0 * 33], s[1 * 33]); o.y = pk2(s[2 * 33], s[3 * 33]); o.z = pk2(s[4 * 33], s[5 * 33]); o.w = pk2(s[6 * 33], s[7 * 33]);
            *(u32x4*)(Wt + (size_t)(n0 + n) * K + k0 + 8 * c) = o; }
        asm volatile("s_waitcnt lgkmcnt(0)" ::: "memory");
    }
}

DI void normmod_f(const float* zin, bool has_ln, const float* lng, const float* lnb, const float* mods_l, int ksh, int ksc, const float* PST, float* MUR, bf16_t* HMOD, int gw, int ngw, int lane) {
    for (int m = gw; m < MT; m += ngw) {
        float mu = 0.f, rs = 1.f;
        if (has_ln) { float s = 0.f, q = 0.f; if (lane < 16) { const f32x2 p = *(const f32x2*)(PST + (size_t)m * 32 + lane * 2); s = p.x; q = p.y; }
            s = wave_sum(s, lane); q = wave_sum(q, lane); mu = s * (1.f / DM); rs = rsqrtf(fmaxf(q * (1.f / DM) - mu * mu, 0.f) + LN_EPS);
            if (lane == 0) *(f32x2*)(MUR + 2 * m) = (f32x2){mu, rs}; }
        const float* mb = mods_l + (size_t)(m / SEQ) * 9216;
#pragma unroll
        for (int j = 0; j < 4; ++j) { const int col = 4 * lane + 256 * j;
            f32x4 x = *(const f32x4*)(zin + (size_t)m * DM + col);
            if (has_ln) x = (x - mu) * rs * *(const f32x4*)(lng + col) + *(const f32x4*)(lnb + col);
            const f32x4 h = x * (*(const f32x4*)(mb + ksc * DM + col) + 1.0f) + *(const f32x4*)(mb + ksh * DM + col);
            *(u32x2*)(HMOD + (size_t)m * DM + col) = (u32x2){pk2(h[0], h[1]), pk2(h[2], h[3])}; }
    }
}

typedef const float* __attribute__((address_space(4))) KPTR_unused;
typedef const float* KPTR_t; typedef __attribute__((address_space(4))) KPTR_t KPTR;
#define IN(i) (kin[i])
struct KArgs { const float* in[37]; float* out; unsigned char* ws; int ph_lo, ph_hi; };

enum { I_X = 0, I_C = 1, I_L0 = 2, I_WIN = 10, I_CONVW = 11, I_CONVB = 12, I_DTB = 13, I_ALOG = 14, I_DSKIP = 15, I_SSDNW = 16, I_QNW = 17, I_WUQ = 18, I_KVNW = 19, I_WUKV = 20, I_WOUT0 = 21,
       I_L1 = 22, I_WUV = 30, I_BUV = 31, I_SLNG = 32, I_SLNB = 33, I_WS = 34, I_BS = 35, I_WOUT1 = 36 };

#define MODS ((float*)(ws + WS_MODS))
#define ROPEC ((float*)(ws + WS_ROPEC))
#define ROPES ((float*)(ws + WS_ROPES))
#define PST ((float*)(ws + WS_PST))
#define MUR ((float*)(ws + WS_MUR))
#define HMOD ((bf16_t*)(ws + WS_HMOD))
#define ZA ((float*)(ws + WS_ZA))
#define ACT ((bf16_t*)(ws + WS_ACT))
#define FFIN ((bf16_t*)(ws + WS_FFIN))
#define FFOUT ((bf16_t*)(ws + WS_FFOUT))
#define PHASE_BEGIN if (ph >= a.ph_lo && ph < a.ph_hi) { int tid = threadIdx.x; asm volatile("" : "+v"(tid)); int bid = blockIdx.x; asm volatile("" : "+s"(bid)); int G = gridDim.x; asm volatile("" : "+s"(G)); const int ngw = G * 8; (void)ngw; const int lane = tid & 63, wave = __builtin_amdgcn_readfirstlane(tid >> 6), gw = bid * 8 + wave; (void)lane; (void)gw; \
    int zo_ = 0; asm volatile("" : "+s"(zo_)); const KPTR* kin = (const KPTR*)__builtin_amdgcn_kernarg_segment_ptr() + zo_; unsigned char* ws = (unsigned char*)kin[38]; float* dout = (float*)kin[37]; (void)ws; (void)dout;
#define PHASE_END   if (ph + 1 < a.ph_hi) grid.sync(); else __syncthreads(); } ++ph;

#define CVT(src, K_, N_, dst, Nout_, mode_) cvt_job(IN(src), K_, N_, (bf16_t*)(ws + (dst)), Nout_, mode_, (LAS float*)(L + wave * 16384), gw, ngw, lane)

#define normmod(zin, has_ln, lng_, lnb_, mods_, ksh, ksc) normmod_f(zin, has_ln, lng_, lnb_, mods_, ksh, ksc, PST, MUR, HMOD, gw, ngw, lane)
#define gemm_ffin() do { pg8::Gemm g{HMOD, FFIN, MT, 2 * DFF, DM, DM, DM}; pg8::StaticOrder S; S.init(MT, 2 * DFF, G, bid); pg8::EpiSwiGLU E{ACT, DFF}; pg8::gemm_phase(L, g, S, E); } while (0)
#define gemm_resid(A_, K_, Wt_, zprev_, has_ln_, lng_, lnb_, gate_, scale_, zout_) do { pg8::Gemm g{A_, Wt_, MT, DM, K_, K_, K_}; pg8::StaticOrder S; S.init(MT, DM, G, bid); \
        pg8::EpiResid<(scale_) < 0.75f> E{zprev_, (has_ln_) ? MUR : nullptr, lng_, lnb_, gate_, zout_, PST}; pg8::gemm_phase(L, g, S, E); } while (0)

template <int layer>
DI void layer_body(const KArgs& a, LAS unsigned char* L, int& ph, cg::grid_group& grid) {
        const int IL = layer ? I_L1 : I_L0;
#define mods_l (MODS + (size_t)layer * 8 * 9216)
#define lng IN(IL + 2)
#define lnb IN(IL + 3)
#define lngp (IN(I_L0 + 2) + 2 * DM)
#define lnbp (IN(I_L0 + 3) + 2 * DM)
#define zin0 (layer ? (const float*)ZA : (const float*)IN(I_X))
#define bufA (layer ? dout : ZA)
#define bufB (layer ? ZA : dout)
        PHASE_BEGIN
            normmod(zin0, layer == 1, lngp, lnbp, mods_l, 0, 1);
            if (layer == 1) {
                CVT(I_L1 + 4, DM, 2 * DFF, WS_FFIN, 2 * DFF, 1);
                CVT(I_L1 + 5, DFF, DM, WS_FFOUT, DM, 0);
                CVT(I_WUV, DM, 4096, WS_WUV1, 4096, 0);
                CVT(I_WOUT1, 2048, DM, WS_WOUT1, DM, 0);
                {
                    for (int i = bid * 512 + tid; i < 16 * 128 * 128 / 4; i += G * 512) { const int e = i * 4, t = (e >> 7) & 127, s0 = e & 127;
                        const f32x4 v = *(const f32x4*)(IN(I_WS) + e);
                        *(u32x2*)(((bf16_t*)(ws + WS_WSB)) + e) = (u32x2){pk2(s0 <= t ? v[0] : 0.f, s0 + 1 <= t ? v[1] : 0.f), pk2(s0 + 2 <= t ? v[2] : 0.f, s0 + 3 <= t ? v[3] : 0.f)}; }
                }
            }
        PHASE_END
        PHASE_BEGIN gemm_ffin(); PHASE_END
        PHASE_BEGIN gemm_resid(ACT, DFF, FFOUT, zin0, layer == 1, lngp, lnbp, mods_l + 2 * DM, 0.5f, bufA); PHASE_END
        PHASE_BEGIN
            normmod(bufA, true, lng, lnb, mods_l, 3, 4);
            CVT(IL + 6, DM, 2 * DFF, WS_FFIN, 2 * DFF, 1);
            CVT(IL + 7, DFF, DM, WS_FFOUT, DM, 0);
        PHASE_END
        if (layer == 0) {
#define ZG ((bf16_t*)(ws + WS_ZG))
#define PROJ2 ((bf16_t*)(ws + WS_PROJ2))
#define XT ((bf16_t*)(ws + WS_XT))
#define BT ((bf16_t*)(ws + WS_BT))
#define BN ((bf16_t*)(ws + WS_BN))
#define CN ((bf16_t*)(ws + WS_CN))
#define DT ((float*)(ws + WS_DT))
#define CS ((float*)(ws + WS_CS))
#define CKVN ((bf16_t*)(ws + WS_CKVN))
#define YCAT ((bf16_t*)(ws + WS_YCAT))
#define KN ((bf16_t*)(ws + WS_KN))
#define VT ((bf16_t*)(ws + WS_VT))
#define Q ((bf16_t*)((char*)dout + DO_Q))
#define CQN ((bf16_t*)((char*)dout + DO_CQN))
#define KPE ((bf16_t*)((char*)dout + DO_KPE))
#define SSQ ((float*)((char*)dout + DO_SSQ))
            PHASE_BEGIN
                pg8::Gemm g{HMOD, (bf16_t*)(ws + WS_WIN), MT, 3328, DM, DM, DM}; pg8::StaticOrder S; S.init(MT, 3328, G, bid);
                pg8::EpiBf16 E{ZG, 1024, PROJ2, 2304, 4}; pg8::gemm_phase(L, g, S, E);
            PHASE_END
            PHASE_BEGIN
                {
                    LAS bf16_t* tin = (LAS bf16_t*)L;
                    for (int u = bid; u < 128 * 24; u += G) {
                        const int tb = u / 24, cb = u % 24, t0 = tb * 128, c0 = cb * 64;
                        __syncthreads();
                        for (int i = tid; i < 131 * 8; i += 512) { const int rr = i >> 3, ch8 = (i & 7) * 8; const int tok = t0 - 3 + rr;
                            u32x4 v = (u32x4){0u, 0u, 0u, 0u};
                            if (!((t0 & (SEQ - 1)) == 0 && rr < 3)) v = *(const u32x4*)(PROJ2 + (size_t)tok * 2304 + c0 + ch8);
                            *(LAS u32x4*)(tin + rr * 64 + ch8) = v; }
                        __syncthreads();
                        const int ch = tid & 63, seg = tid >> 6, cg_ = c0 + ch;
                        const float w0 = IN(I_CONVW)[cg_], w1 = IN(I_CONVW)[1536 + cg_], w2 = IN(I_CONVW)[2 * 1536 + cg_], w3 = IN(I_CONVW)[3 * 1536 + cg_], cbias = IN(I_CONVB)[cg_];
                        float iv[19];
#pragma unroll
                        for (int i = 0; i < 19; ++i) iv[i] = bf1(tin[(seg * 16 + i) * 64 + ch]);
                        float o[16];
#pragma unroll
                        for (int i = 0; i < 16; ++i) o[i] = silu_f(cbias + w0 * iv[i] + w1 * iv[i + 1] + w2 * iv[i + 2] + w3 * iv[i + 3]);
                        const int bb = t0 / SEQ, s0 = (t0 & (SEQ - 1)) + seg * 16;
                        u32x4 p0, p1; p0.x = pk2(o[0], o[1]); p0.y = pk2(o[2], o[3]); p0.z = pk2(o[4], o[5]); p0.w = pk2(o[6], o[7]);
                        p1.x = pk2(o[8], o[9]); p1.y = pk2(o[10], o[11]); p1.z = pk2(o[12], o[13]); p1.w = pk2(o[14], o[15]);
                        if (cg_ < 1024) { bf16_t* d = XT + ((size_t)bb * 1024 + cg_) * SEQ + s0; *(u32x4*)d = p0; *(u32x4*)(d + 8) = p1; }
                        else if (cg_ < 1280) { const int n = cg_ - 1024; bf16_t* d = BT + ((size_t)bb * 256 + n) * SEQ + s0; *(u32x4*)d = p0; *(u32x4*)(d + 8) = p1;
#pragma unroll
                            for (int i = 0; i < 16; ++i) BN[(size_t)(t0 + seg * 16 + i) * 256 + n] = tobf(o[i]); }
                        else { const int n = cg_ - 1280;
#pragma unroll
                            for (int i = 0; i < 16; ++i) CN[(size_t)(t0 + seg * 16 + i) * 256 + n] = tobf(o[i]); }
                    }
                    __syncthreads();
                }
                {
                    LAS float* dtl = (LAS float*)(L + 32768);
                    for (int u = bid; u < 128; u += G) {
                        __syncthreads();
                        for (int i = tid; i < 2048; i += 512) { const int tk = i >> 4, h = i & 15;
                            const float x = bf1(PROJ2[(size_t)(u * 128 + tk) * 2304 + 1536 + h]) + IN(I_DTB)[h];
                            dtl[i] = fmaxf(x, 0.f) + log1pf(__expf(-fabsf(x))); }
                        __syncthreads();
                        if (tid < 16) { const int h = tid, bb = u >> 4, s0 = (u & 15) * 128; const float av = -__expf(IN(I_ALOG)[h]); float cs = 0.f;
                            float* dp = DT + ((size_t)bb * 16 + h) * SEQ + s0; float* cp = CS + ((size_t)bb * 16 + h) * SEQ + s0;
                            for (int t = 0; t < 128; ++t) { const float d = dtl[t * 16 + h]; cs += d * av; dp[t] = d; cp[t] = cs; } }
                    }
                    __syncthreads();
                }
                for (int m = gw; m < MT; m += ngw) {
                    const bf16_t* pr = PROJ2 + (size_t)m * 2304;
                    float x[6]; float s = 0.f;
#pragma unroll
                    for (int j = 0; j < 3; ++j) { const unsigned v = *(const unsigned*)(pr + 1552 + 2 * lane + 128 * j); x[2 * j] = bflo(v); x[2 * j + 1] = bfhi(v); s += x[2 * j] * x[2 * j] + x[2 * j + 1] * x[2 * j + 1]; }
                    float rs = rsqrtf(wave_sum(s, lane) * (1.f / 384.f) + LN_EPS);
#pragma unroll
                    for (int j = 0; j < 3; ++j) { const int e = 2 * lane + 128 * j; *(unsigned*)(CQN + (size_t)m * 384 + e) = pk2(x[2 * j] * rs * IN(I_QNW)[e], x[2 * j + 1] * rs * IN(I_QNW)[e + 1]); }
                    const u32x2 kv = *(const u32x2*)(pr + 1936 + 4 * lane);
                    const float k0 = bflo(kv.x), k1 = bfhi(kv.x), k2 = bflo(kv.y), k3 = bfhi(kv.y);
                    rs = rsqrtf(wave_sum(k0 * k0 + k1 * k1 + k2 * k2 + k3 * k3, lane) * (1.f / 256.f) + LN_EPS);
                    const f32x4 kw = *(const f32x4*)(IN(I_KVNW) + 4 * lane);
                    *(u32x2*)(CKVN + (size_t)m * 256 + 4 * lane) = (u32x2){pk2(k0 * rs * kw[0], k1 * rs * kw[1]), pk2(k2 * rs * kw[2], k3 * rs * kw[3])};
                    if (lane < 32) { const int pos = m & (SEQ - 1); const float x1 = bf1(pr[2192 + lane]), x2 = bf1(pr[2192 + 32 + lane]);
                        const float c = ROPEC[pos * 32 + lane], sn = ROPES[pos * 32 + lane];
                        KPE[(size_t)m * 64 + lane] = tobf(x1 * c - x2 * sn); KPE[(size_t)m * 64 + 32 + lane] = tobf(x2 * c + x1 * sn); }
                }
            PHASE_END
            PHASE_BEGIN
                { pg8::Gemm g{CQN, (bf16_t*)(ws + WS_WUQ), MT, 1536, 384, 384, 384}; pg8::StaticOrder S; S.init(MT, 1536, G, bid);
                  pg8::EpiQRope E{Q, ROPEC, ROPES}; pg8::gemm_phase(L, g, S, E); }
                { pg8::Gemm g{CKVN, (bf16_t*)(ws + WS_WUK), MT, 1024, 256, 256, 256}; pg8::StaticOrder S; S.init(MT, 1024, G, bid);
                  pg8::EpiBf16 E{KN, 1024, KN, 1024, 0}; pg8::gemm_phase(L, g, S, E); }
                { pg8::Gemm g{(bf16_t*)(ws + WS_WUV0), CKVN, 1024, MT, 256, 256, 256}; pg8::StaticOrder S; S.init(1024, MT, G, bid);
                  pg8::EpiBf16 E{VT, MT, VT, MT, 0}; pg8::gemm_phase(L, g, S, E); }
            PHASE_END
            PHASE_BEGIN
                const int r = lane & 31, hh = lane >> 5;
#ifndef NO_SSD
                if (bid < 128) {
                    constexpr int BL = 0, CL = 34816, WL = 69632, XL = 104448, SL = 121856, DTL = 139264, CSL = 139776, RS = 272;
                    const int b = bid >> 4, hd = bid & 15, g = hd >> 3, pb = wave >> 2, qb = wave & 3;
                    const float dskip = IN(I_DSKIP)[hd];
                    const float* dtp = DT + ((size_t)b * 16 + hd) * SEQ; const float* csp = CS + ((size_t)b * 16 + hd) * SEQ;
                    f32x16 st = zero16();
                    for (int c = 0; c < 16; ++c) {
                        const int t0 = c * 128; const size_t tokb = (size_t)b * SEQ + t0;
                        __syncthreads();
                        if (tid < 128) ((LAS float*)(L + DTL))[tid] = dtp[t0 + tid];
                        else if (tid < 256) ((LAS float*)(L + CSL))[tid - 128] = csp[t0 + tid - 128];
                        const float cse = csp[t0 + 127];
#pragma unroll
                        for (int i = 0; i < 4; ++i) { const int ci = tid + 512 * i, row = ci >> 4, ch = ci & 15;
                            *(LAS u32x4*)(L + BL + row * RS + ch * 16) = *(const u32x4*)(BN + (tokb + row) * 256 + g * 128 + ch * 8);
                            *(LAS u32x4*)(L + CL + row * RS + ch * 16) = *(const u32x4*)(CN + (tokb + row) * 256 + g * 128 + ch * 8);
                            const u32x4 bt = *(const u32x4*)(BT + ((size_t)b * 256 + g * 128 + row) * SEQ + t0 + ch * 8);
                            const f32x4 d0 = *(const f32x4*)(dtp + t0 + ch * 8), d1 = *(const f32x4*)(dtp + t0 + ch * 8 + 4);
                            const f32x4 c0 = *(const f32x4*)(csp + t0 + ch * 8), c1 = *(const f32x4*)(csp + t0 + ch * 8 + 4);
                            u32x4 o;
                            o.x = pk2(bflo(bt.x) * d0[0] * __expf(cse - c0[0]), bfhi(bt.x) * d0[1] * __expf(cse - c0[1]));
                            o.y = pk2(bflo(bt.y) * d0[2] * __expf(cse - c0[2]), bfhi(bt.y) * d0[3] * __expf(cse - c0[3]));
                            o.z = pk2(bflo(bt.z) * d1[0] * __expf(cse - c1[0]), bfhi(bt.z) * d1[1] * __expf(cse - c1[1]));
                            o.w = pk2(bflo(bt.w) * d1[2] * __expf(cse - c1[2]), bfhi(bt.w) * d1[3] * __expf(cse - c1[3]));
                            *(LAS u32x4*)(L + WL + row * RS + ch * 16) = o; }
#pragma unroll
                        for (int i = 0; i < 2; ++i) { const int ci = tid + 512 * i, p = ci >> 4, ch = ci & 15;
                            *(LAS u32x4*)(L + XL + p * RS + ch * 16) = *(const u32x4*)(XT + ((size_t)b * 1024 + hd * 64 + p) * SEQ + t0 + ch * 8); }
#pragma unroll
                        for (int i = 0; i < 16; ++i) *(LAS bf16_t*)(L + SL + (32 * pb + crow(i, hh)) * RS + (32 * qb + r) * 2) = tobf(st[i]);
                        __syncthreads();
                        const LAS float* dtl = (const LAS float*)(L + DTL); const LAS float* csl = (const LAS float*)(L + CSL);
                        const int lb = qb, l = 32 * lb + r; const float csL = csl[l];
                        f32x16 y = zero16();
#pragma unroll
                        for (int ks = 0; ks < 8; ++ks) y = mfma32(*(const LAS bf16x8*)(L + SL + (32 * pb + r) * RS + (16 * ks + 8 * hh) * 2), *(const LAS bf16x8*)(L + CL + l * RS + (16 * ks + 8 * hh) * 2), y);
                        { const float e = __expf(csL);
#pragma unroll
                          for (int i = 0; i < 16; ++i) y[i] *= e; }
                        for (int sb = 0; sb <= lb; ++sb) {
                            f32x16 cb = zero16();
#pragma unroll
                            for (int ks = 0; ks < 8; ++ks) cb = mfma32(*(const LAS bf16x8*)(L + BL + (32 * sb + r) * RS + (16 * ks + 8 * hh) * 2), *(const LAS bf16x8*)(L + CL + l * RS + (16 * ks + 8 * hh) * 2), cb);
#pragma unroll
                            for (int i = 0; i < 16; ++i) { const int s = 32 * sb + crow(i, hh); cb[i] = (s <= l) ? cb[i] * __expf(csL - csl[s]) * dtl[s] : 0.f; }
#pragma unroll
                            for (int s2 = 0; s2 < 2; ++s2) {
                                u32x4 pf; pf.x = pk2(cb[8 * s2], cb[8 * s2 + 1]); pf.y = pk2(cb[8 * s2 + 2], cb[8 * s2 + 3]); pf.z = pk2(cb[8 * s2 + 4], cb[8 * s2 + 5]); pf.w = pk2(cb[8 * s2 + 6], cb[8 * s2 + 7]);
                                const LAS unsigned char* xp = L + XL + (32 * pb + r) * RS + (32 * sb + 16 * s2 + 4 * hh) * 2;
                                const u32x2 x0 = *(const LAS u32x2*)xp, x1 = *(const LAS u32x2*)(xp + 16);
                                const u32x4 xa = (u32x4){x0.x, x0.y, x1.x, x1.y};
                                y = mfma32(__builtin_bit_cast(bf16x8, xa), __builtin_bit_cast(bf16x8, pf), y); }
                        }
                        { float ssq = 0.f; const size_t tok = tokb + l;
#pragma unroll
                          for (int q4 = 0; q4 < 4; ++q4) { const int p0 = 32 * pb + 8 * q4 + 4 * hh;
                              const u32x2 zz = *(const u32x2*)(ZG + tok * 1024 + hd * 64 + p0);
                              const float zf[4] = {bflo(zz.x), bfhi(zz.x), bflo(zz.y), bfhi(zz.y)}; float o[4];
#pragma unroll
                              for (int j = 0; j < 4; ++j) { const float xv = bf1(*(const LAS bf16_t*)(L + XL + (p0 + j) * RS + l * 2));
                                  o[j] = (y[4 * q4 + j] + dskip * xv) * silu_f(zf[j]); ssq += o[j] * o[j]; }
                              *(u32x2*)(YCAT + tok * 2048 + hd * 64 + p0) = (u32x2){pk2(o[0], o[1]), pk2(o[2], o[3])}; }
                          ssq += shx(ssq, 32, lane);
                          if (hh == 0) SSQ[tok * 32 + hd * 2 + pb] = ssq; }
                        { const float dec = __expf(cse);
#pragma unroll
                          for (int i = 0; i < 16; ++i) st[i] *= dec;
#pragma unroll
                          for (int ks = 0; ks < 8; ++ks) st = mfma32(*(const LAS bf16x8*)(L + XL + (32 * pb + r) * RS + (16 * ks + 8 * hh) * 2), *(const LAS bf16x8*)(L + WL + (32 * qb + r) * RS + (16 * ks + 8 * hh) * 2), st); }
                    }
                }
#endif
#ifndef NO_ATT
                {
                    constexpr int KL = 0, KRS = 400, VL = 25600, VRS = 144, UW = 147000;
                    unsigned* ctr = (unsigned*)(ws + WS_CTL);
                    for (;;) {
                        __syncthreads();
                        if (tid == 0) *(LAS unsigned*)(L + UW) = atomicAdd(ctr, 1u);
                        __syncthreads();
                        const unsigned u = *(LAS unsigned*)(L + UW);
                        if (u >= 512u) break;
                        const int j = 7 - (int)(u >> 6), bh = (int)(u & 63), b = bh >> 3, h = bh & 7;
                        const int q0 = 256 * j, qw = q0 + 32 * wave, nt = 4 * j + 4, ktmax = 4 * j + (wave >> 1);
                        const size_t tb = (size_t)b * SEQ;
                        bf16x8 qf[12];
#pragma unroll
                        for (int ks = 0; ks < 12; ++ks) qf[ks] = *(const bf16x8*)(Q + (tb + qw + r) * 1536 + h * 192 + 16 * ks + 8 * hh);
                        f32x16 o[4]; o[0] = zero16(); o[1] = zero16(); o[2] = zero16(); o[3] = zero16();
                        float mrun = -1e30f, lrun = 0.f;
                        u32x4 kreg[3], vreg[2];
#define ldtile(kt_) do { const int k0 = 64 * (kt_); \
                            _Pragma("unroll") for (int i = 0; i < 3; ++i) { const int ci = tid + 512 * i, key = ci / 24, cc = ci % 24; \
                                kreg[i] = cc < 16 ? *(const u32x4*)(KN + (tb + k0 + key) * 1024 + h * 128 + cc * 8) : *(const u32x4*)(KPE + (tb + k0 + key) * 64 + (cc - 16) * 8); } \
                            _Pragma("unroll") for (int i = 0; i < 2; ++i) { const int ci = tid + 512 * i, d = ci >> 3, g8 = ci & 7; \
                                vreg[i] = *(const u32x4*)(VT + ((size_t)h * 128 + d) * MT + tb + k0 + g8 * 8); } } while (0)
                        ldtile(0);
                        for (int kt = 0; kt < nt; ++kt) {
                            __syncthreads();
#pragma unroll
                            for (int i = 0; i < 3; ++i) { const int ci = tid + 512 * i, key = ci / 24, cc = ci % 24; *(LAS u32x4*)(L + KL + key * KRS + cc * 16) = kreg[i]; }
#pragma unroll
                            for (int i = 0; i < 2; ++i) { const int ci = tid + 512 * i, d = ci >> 3, g8 = ci & 7; const int pos = 32 * (g8 >> 2) + 16 * ((g8 >> 1) & 1) + 4 * (g8 & 1);
                                *(LAS u32x2*)(L + VL + d * VRS + pos * 2) = (u32x2){vreg[i].x, vreg[i].y};
                                *(LAS u32x2*)(L + VL + d * VRS + (pos + 8) * 2) = (u32x2){vreg[i].z, vreg[i].w}; }
                            __syncthreads();
                            if (kt + 1 < nt) ldtile(kt + 1);
                            if (kt <= ktmax) {
                                f32x16 s0 = zero16(), s1 = zero16();
#pragma unroll
                                for (int ks = 0; ks < 12; ++ks) {
                                    s0 = mfma32(*(const LAS bf16x8*)(L + KL + r * KRS + (16 * ks + 8 * hh) * 2), qf[ks], s0);
                                    s1 = mfma32(*(const LAS bf16x8*)(L + KL + (32 + r) * KRS + (16 * ks + 8 * hh) * 2), qf[ks], s1); }
                                if (kt == ktmax) { const int qp = qw + r, kb0 = 64 * kt;
#pragma unroll
                                    for (int i = 0; i < 16; ++i) { if (kb0 + crow(i, hh) > qp) s0[i] = -1e30f; if (kb0 + 32 + crow(i, hh) > qp) s1[i] = -1e30f; } }
                                float mx = -1e30f;
#pragma unroll
                                for (int i = 0; i < 16; ++i) mx = fmaxf(mx, fmaxf(s0[i], s1[i]));
                                mx = fmaxf(mx, shx(mx, 32, lane));
                                const float mnew = fmaxf(mrun, mx), al = __builtin_amdgcn_exp2f(mrun - mnew);
                                float rsum = 0.f;
#pragma unroll
                                for (int i = 0; i < 16; ++i) { s0[i] = __builtin_amdgcn_exp2f(s0[i] - mnew); s1[i] = __builtin_amdgcn_exp2f(s1[i] - mnew); rsum += s0[i] + s1[i]; }
                                rsum += shx(rsum, 32, lane);
                                lrun = lrun * al + rsum; mrun = mnew;
#pragma unroll
                                for (int db = 0; db < 4; ++db)
#pragma unroll
                                    for (int i = 0; i < 16; ++i) o[db][i] *= al;
#pragma unroll
                                for (int kb = 0; kb < 2; ++kb)
#pragma unroll
                                    for (int s2 = 0; s2 < 2; ++s2) { const f32x16& sv = kb ? s1 : s0;
                                        u32x4 pf; pf.x = pk2(sv[8 * s2], sv[8 * s2 + 1]); pf.y = pk2(sv[8 * s2 + 2], sv[8 * s2 + 3]); pf.z = pk2(sv[8 * s2 + 4], sv[8 * s2 + 5]); pf.w = pk2(sv[8 * s2 + 6], sv[8 * s2 + 7]);
#pragma unroll
                                        for (int db = 0; db < 4; ++db)
                                            o[db] = mfma32(*(const LAS bf16x8*)(L + VL + (32 * db + r) * VRS + (32 * kb + 16 * s2 + 8 * hh) * 2), __builtin_bit_cast(bf16x8, pf), o[db]); }
                            }
                        }
                        const float inv = 1.0f / lrun;
#pragma unroll
                        for (int db = 0; db < 4; ++db)
#pragma unroll
                            for (int q4 = 0; q4 < 4; ++q4) { const int d0 = 32 * db + 8 * q4 + 4 * hh;
                                *(u32x2*)(YCAT + (tb + qw + r) * 2048 + 1024 + h * 128 + d0) = (u32x2){pk2(o[db][4 * q4] * inv, o[db][4 * q4 + 1] * inv), pk2(o[db][4 * q4 + 2] * inv, o[db][4 * q4 + 3] * inv)}; }
                    }
                }
#endif
            PHASE_END
            PHASE_BEGIN
                for (int m = gw; m < MT; m += ngw) {
                    float s = (lane < 32) ? SSQ[(size_t)m * 32 + lane] : 0.f;
                    s += shx(s, 1, lane); s += shx(s, 2, lane); s += shx(s, 4, lane); s += shx(s, 8, lane);
                    const float r0 = rsqrtf(rdl(s, 0) * (1.f / 512.f) + LN_EPS), r1 = rsqrtf(rdl(s, 16) * (1.f / 512.f) + LN_EPS);
#pragma unroll
                    for (int j = 0; j < 4; ++j) { const int col = 4 * lane + 256 * j; const float rr = col < 512 ? r0 : r1;
                        const u32x2 v = *(const u32x2*)(YCAT + (size_t)m * 2048 + col); const f32x4 w = *(const f32x4*)(IN(I_SSDNW) + col);
                        *(u32x2*)(YCAT + (size_t)m * 2048 + col) = (u32x2){pk2(bflo(v.x) * rr * w[0], bfhi(v.x) * rr * w[1]), pk2(bflo(v.y) * rr * w[2], bfhi(v.y) * rr * w[3])}; }
                }
            PHASE_END
            PHASE_BEGIN gemm_resid(YCAT, 2048, (bf16_t*)(ws + WS_WOUT0), ZA, true, lng, lnb, mods_l + 5 * DM, 1.0f, dout); PHASE_END
        } else {
#define UV ((bf16_t*)(ws + WS_UV))
#define VST ((float*)(ws + WS_VST))
#define WSB ((bf16_t*)(ws + WS_WSB))
            PHASE_BEGIN
                pg8::Gemm g{HMOD, (bf16_t*)(ws + WS_WUV1), MT, 4096, DM, DM, DM}; pg8::StaticOrder S; S.init(MT, 4096, G, bid);
                pg8::EpiGeluUV E{UV, IN(I_BUV), VST}; pg8::gemm_phase(L, g, S, E);
            PHASE_END
            PHASE_BEGIN
                constexpr int WLo = 0, VLo = 34816, MRL = 69632, RS = 272;
                const int r = lane & 31, hh = lane >> 5, tbk = wave & 3, dh = wave >> 2;
                for (int u = bid; u < 2048; u += G) {
                    const int g = u & 15, bc = u >> 4; const size_t tok0 = (size_t)bc * 128;
                    __syncthreads();
                    if (tid < 128) { float s = 0.f, q = 0.f; const float* vp = VST + (tok0 + tid) * 64;
#pragma unroll
                        for (int i = 0; i < 16; ++i) { const f32x4 v = *(const f32x4*)(vp + 4 * i); s += v[0] + v[2]; q += v[1] + v[3]; }
                        const float mu = s * (1.f / 2048.f), rs = rsqrtf(fmaxf(q * (1.f / 2048.f) - mu * mu, 0.f) + LN_EPS);
                        *(LAS f32x2*)(L + MRL + tid * 8) = (f32x2){mu, rs}; }
#pragma unroll
                    for (int i = 0; i < 4; ++i) { const int ci = tid + 512 * i, row = ci >> 4, ch = ci & 15;
                        *(LAS u32x4*)(L + WLo + row * RS + ch * 16) = *(const u32x4*)(WSB + ((size_t)g * 128 + row) * 128 + ch * 8); }
                    __syncthreads();
#pragma unroll
                    for (int i = 0; i < 4; ++i) { const int ci = tid + 512 * i, s = ci >> 4, dc = ci & 15, d0 = dc * 8;
                        const u32x4 v = *(const u32x4*)(UV + (tok0 + s) * 4096 + 2048 + g * 128 + d0);
                        const f32x2 mr = *(const LAS f32x2*)(L + MRL + s * 8);
                        const f32x4 g0 = *(const f32x4*)(IN(I_SLNG) + g * 128 + d0), g1 = *(const f32x4*)(IN(I_SLNG) + g * 128 + d0 + 4);
                        const f32x4 b0 = *(const f32x4*)(IN(I_SLNB) + g * 128 + d0), b1 = *(const f32x4*)(IN(I_SLNB) + g * 128 + d0 + 4);
                        const float vv[8] = {bflo(v.x), bfhi(v.x), bflo(v.y), bfhi(v.y), bflo(v.z), bfhi(v.z), bflo(v.w), bfhi(v.w)};
#pragma unroll
                        for (int e = 0; e < 8; ++e) { const float gg = e < 4 ? g0[e & 3] : g1[e & 3], bb = e < 4 ? b0[e & 3] : b1[e & 3];
                            *(LAS bf16_t*)(L + VLo + (d0 + e) * RS + s * 2) = tobf((vv[e] - mr.x) * mr.y * gg + bb); } }
                    __syncthreads();
                    f32x16 acc0 = zero16(), acc1 = zero16();
                    const int t = 32 * tbk + r;
                    for (int ks = 0; ks < 2 * (tbk + 1); ++ks) { const bf16x8 wf = *(const LAS bf16x8*)(L + WLo + t * RS + (16 * ks + 8 * hh) * 2);
                        acc0 = mfma32(*(const LAS bf16x8*)(L + VLo + (64 * dh + r) * RS + (16 * ks + 8 * hh) * 2), wf, acc0);
                        acc1 = mfma32(*(const LAS bf16x8*)(L + VLo + (64 * dh + 32 + r) * RS + (16 * ks + 8 * hh) * 2), wf, acc1); }
                    const float bs = IN(I_BS)[g * 128 + t];
                    bf16_t* up = UV + (tok0 + t) * 4096 + g * 128;
#pragma unroll
                    for (int db = 0; db < 2; ++db)
#pragma unroll
                        for (int q4 = 0; q4 < 4; ++q4) { const int d0 = 64 * dh + 32 * db + 8 * q4 + 4 * hh; const f32x16& ac = db ? acc1 : acc0;
                            const u32x2 uu = *(const u32x2*)(up + d0);
                            *(u32x2*)(up + d0) = (u32x2){pk2(bflo(uu.x) * (ac[4 * q4] + bs), bfhi(uu.x) * (ac[4 * q4 + 1] + bs)), pk2(bflo(uu.y) * (ac[4 * q4 + 2] + bs), bfhi(uu.y) * (ac[4 * q4 + 3] + bs))}; }
                }
            PHASE_END
            PHASE_BEGIN
                pg8::Gemm g{UV, (bf16_t*)(ws + WS_WOUT1), MT, DM, 2048, 4096, 2048}; pg8::StaticOrder S; S.init(MT, DM, G, bid);
                pg8::EpiResid<false> E{bufA, MUR, lng, lnb, mods_l + 5 * DM, bufB, PST}; pg8::gemm_phase(L, g, S, E);
            PHASE_END
        }
        PHASE_BEGIN normmod(bufB, true, lng + DM, lnb + DM, mods_l, 6, 7); PHASE_END
        PHASE_BEGIN gemm_ffin(); PHASE_END
        PHASE_BEGIN gemm_resid(ACT, DFF, FFOUT, bufB, true, lng + DM, lnb + DM, mods_l + 8 * DM, 0.5f, bufA); PHASE_END
    }

__global__ void __launch_bounds__(512, 2) mega_fwd(KArgs a) {
    extern __shared__ __attribute__((aligned(16))) unsigned char lds_raw[];
    LAS unsigned char* L = (LAS unsigned char*)lds_raw;
    cg::grid_group grid = cg::this_grid();
    int ph = 0;
    PHASE_BEGIN
        {
            LAS float* sc = (LAS float*)L;
            LAS float* red = (LAS float*)(L + 32768);
            bool loaded = false;
            for (int it = bid; it < 288; it += G) {
                if (!loaded) { for (int i = tid; i < 8192; i += 512) sc[i] = silu_f(IN(I_C)[i]); loaded = true; }
                __syncthreads();
                const int l = it / 144, j0 = (it % 144) * 64, col = tid & 63, kg = tid >> 6;
                const float* W = IN(l ? I_L1 : I_L0) + j0 + col;
                float acc[8];
#pragma unroll
                for (int b = 0; b < 8; ++b) acc[b] = 0.f;
                for (int k = kg * 128; k < kg * 128 + 128; ++k) { const float w = W[(size_t)k * 9216];
#pragma unroll
                    for (int b = 0; b < 8; ++b) acc[b] += sc[b * 1024 + k] * w; }
#pragma unroll
                for (int b = 0; b < 8; ++b) red[(kg * 8 + b) * 64 + col] = acc[b];
                __syncthreads();
                { const int b = tid >> 6; float s = IN((l ? I_L1 : I_L0) + 1)[j0 + col];
#pragma unroll
                    for (int k8 = 0; k8 < 8; ++k8) s += red[(k8 * 8 + b) * 64 + col];
                    MODS[(size_t)(l * 8 + b) * 9216 + j0 + col] = s; }
            }
            __syncthreads();
        }
        for (int i = bid * 512 + tid; i < SEQ * 32; i += G * 512) { const int pos = i >> 5, f = i & 31;
            const float inv = 1.0f / powf(10000.0f, (float)(2 * f) / 64.0f); const float ang = (float)pos * inv;
            ROPEC[i] = cosf(ang); ROPES[i] = sinf(ang); }
        CVT(I_L0 + 4, DM, 2 * DFF, WS_FFIN, 2 * DFF, 1);
        CVT(I_L0 + 5, DFF, DM, WS_FFOUT, DM, 0);
        CVT(I_WIN, DM, 3280, WS_WIN, 3328, 0);
        CVT(I_WUQ, 384, 1536, WS_WUQ, 1536, 2);
        CVT(I_WUKV, 256, 2048, WS_WUK, 1024, 3);
        CVT(I_WUKV, 256, 2048, WS_WUV0, 1024, 4);
        CVT(I_WOUT0, 2048, DM, WS_WOUT0, DM, 0);
    PHASE_END

    layer_body<0>(a, L, ph, grid);
    layer_body<1>(a, L, ph, grid);
#undef lng
#undef lnb
    PHASE_BEGIN
        const float* lngF = IN(I_L1 + 2) + 2 * DM; const float* lnbF = IN(I_L1 + 3) + 2 * DM;
        for (int m = gw; m < MT; m += ngw) {
            float s = 0.f, q = 0.f; if (lane < 16) { const f32x2 p = *(const f32x2*)(PST + (size_t)m * 32 + lane * 2); s = p.x; q = p.y; }
            s = wave_sum(s, lane); q = wave_sum(q, lane); const float mu = s * (1.f / DM), rs = rsqrtf(fmaxf(q * (1.f / DM) - mu * mu, 0.f) + LN_EPS);
#pragma unroll
            for (int j = 0; j < 4; ++j) { const int col = 4 * lane + 256 * j;
                const f32x4 x = *(const f32x4*)(dout + (size_t)m * DM + col);
                *(f32x4*)(dout + (size_t)m * DM + col) = (x - mu) * rs * *(const f32x4*)(lngF + col) + *(const f32x4*)(lnbF + col); }
        }
    PHASE_END
}

constexpr int N_PHASES = 64;

extern "C" void kernel_launch(void* const* d_in, const int* in_sizes, int n_in, void* d_out, int out_size, void* d_ws, size_t ws_size, hipStream_t stream) {
    static int grid = 0;
    if (grid == 0) {
        int dev = 0, cus = 0, per_cu = 0;
        hipGetDevice(&dev); hipDeviceGetAttribute(&cus, hipDeviceAttributeMultiprocessorCount, dev);
        hipFuncSetAttribute((const void*)mega_fwd, hipFuncAttributeMaxDynamicSharedMemorySize, LDS_BYTES);
        hipOccupancyMaxActiveBlocksPerMultiprocessor(&per_cu, (const void*)mega_fwd, 512, LDS_BYTES);
        if (per_cu < 1) { fprintf(stderr, "kernel_launch: occupancy query says %d blocks/CU\n", per_cu); per_cu = 1; }
        grid = cus;
        if (n_in != 37 || ws_size < WS_END) fprintf(stderr, "kernel_launch: unexpected n_in %d / ws_size %zu (need %zu)\n", n_in, ws_size, (size_t)WS_END);
    }
    hipMemsetAsync((char*)d_ws + WS_CTL, 0, 4096, stream);
    KArgs a{};
    for (int i = 0; i < 37; ++i) a.in[i] = (const float*)d_in[i];
    a.out = (float*)d_out; a.ws = (unsigned char*)d_ws;
#if MK_MULTI
    for (int p = 0; p < 25; ++p) { a.ph_lo = p; a.ph_hi = p + 1; hipLaunchKernelGGL(mega_fwd, dim3(grid), dim3(512), LDS_BYTES, stream, a); }
#else
    a.ph_lo = 0; a.ph_hi = N_PHASES;
    void* args[] = {&a};
    hipError_t e = hipLaunchCooperativeKernel((const void*)mega_fwd, dim3(grid), dim3(512), args, LDS_BYTES, stream);
    if (e != hipSuccess) fprintf(stderr, "cooperative launch failed: %s (grid %d)\n", hipGetErrorString(e), grid);
#endif
}
```

```cpp
#include <hip/hip_runtime.h>
#include <hip/hip_cooperative_groups.h>
#include <cstdio>
#include <cstdint>
namespace cg = cooperative_groups;

#define DI __device__ __forceinline__
#define LAS __attribute__((address_space(3)))
typedef unsigned short bf16_t;
typedef short bf16x8 __attribute__((ext_vector_type(8)));
typedef float f32x4 __attribute__((ext_vector_type(4)));
typedef float f32x2 __attribute__((ext_vector_type(2)));
typedef float f32x16 __attribute__((ext_vector_type(16)));
typedef unsigned u32x4 __attribute__((ext_vector_type(4)));
typedef unsigned u32x2 __attribute__((ext_vector_type(2)));

#ifndef MK_MULTI
#define MK_MULTI 0
#endif

constexpr int DM = 1024, NB = 8, SEQ = 2048, MT = NB * SEQ, DFF = 2816;
constexpr float LN_EPS = 1e-5f;
constexpr float DN_ALPHA = 1.41421356237f;
constexpr float QSCALE = 0.07216878364870322f * 1.4426950408889634f;

constexpr size_t MiB = 1u << 20;
constexpr size_t WS_CTL = 0, WS_MUR = MiB / 8, WS_MODS = MiB / 4, WS_ROPEC = 1 * MiB, WS_ROPES = MiB + MiB / 4, WS_PST = 2 * MiB;
constexpr size_t WS_FFIN = 4 * MiB, WS_FFOUT = 15 * MiB;
constexpr size_t WS_WIN = 21 * MiB, WS_WUQ = 27 * MiB + MiB / 2, WS_WUK = 28 * MiB + 3 * MiB / 4, WS_WUV0 = 29 * MiB + MiB / 4, WS_WOUT0 = 30 * MiB;
constexpr size_t WS_WUV1 = 21 * MiB, WS_WOUT1 = 29 * MiB, WS_WSB = 33 * MiB;
constexpr size_t WS_ZA = 34 * MiB, WS_HMOD = 98 * MiB, WS_R = 130 * MiB;
constexpr size_t WS_ACT = WS_R;
constexpr size_t WS_ZG = WS_R, WS_XT = WS_R + 32 * MiB, WS_BT = WS_R + 64 * MiB, WS_BN = WS_R + 72 * MiB, WS_CN = WS_R + 80 * MiB, WS_DT = WS_R + 88 * MiB, WS_CS = WS_R + 89 * MiB,
                 WS_CKVN = WS_R + 90 * MiB, WS_PROJ2 = WS_R + 98 * MiB, WS_YCAT = WS_R + 90 * MiB, WS_KN = WS_R + 154 * MiB;
constexpr size_t WS_VT = WS_HMOD;
constexpr size_t WS_UV = WS_R, WS_VST = WS_R + 128 * MiB;
constexpr size_t WS_END = 316 * MiB;
constexpr size_t DO_Q = 0, DO_CQN = 48 * MiB, DO_KPE = 60 * MiB, DO_SSQ = 62 * MiB;
constexpr int LDS_BYTES = 147456;

DI unsigned pk2(float lo, float hi) { typedef __bf16 b2 __attribute__((ext_vector_type(2))); f32x2 v = {lo, hi}; b2 b = __builtin_convertvector(v, b2); return __builtin_bit_cast(unsigned, b); }
DI float bflo(unsigned u) { return __uint_as_float(u << 16); }
DI float bfhi(unsigned u) { return __uint_as_float(u & 0xffff0000u); }
DI float bf1(bf16_t b) { return __uint_as_float(((unsigned)b) << 16); }
DI bf16_t tobf(float f) { return (bf16_t)(pk2(f, 0.f) & 0xffffu); }
DI float silu_f(float a) { return a * __builtin_amdgcn_rcpf(1.f + __expf(-a)); }
DI float shx(float v, int o, int lane) { return __builtin_bit_cast(float, __builtin_amdgcn_ds_bpermute((lane ^ o) << 2, __builtin_bit_cast(int, v))); }
DI float rdl(float v, int l) { return __builtin_bit_cast(float, __builtin_amdgcn_readlane(__builtin_bit_cast(int, v), l)); }
DI float wave_sum(float v, int lane) {
#pragma unroll
    for (int o = 1; o < 64; o <<= 1) v += shx(v, o, lane);
    return v;
}
DI f32x16 mfma32(bf16x8 a, bf16x8 b, f32x16 c) { return __builtin_amdgcn_mfma_f32_32x32x16_bf16(a, b, c, 0, 0, 0); }
DI int crow(int i, int hh) { return (i & 3) + 8 * (i >> 2) + 4 * hh; }
DI f32x16 zero16() { f32x16 z; for (int i = 0; i < 16; ++i) z[i] = 0.f; return z; }

namespace pg8 {
constexpr int BM = 256, BK = 64, HALF = 128, HTB = HALF * BK * 2, STAGE_BYTES = 8 * HTB, NXCD = 8, WGM = 8;
__host__ __device__ __forceinline__ int lds_byte(int r, int c) { const int st = (r >> 4) * 2 + (c >> 5), rr = r & 15, cc = c & 31, ob = rr * 64 + cc * 2; return st * 1024 + (ob ^ (((ob >> 9) & 1) << 5)); }
__host__ __device__ __forceinline__ void stage_rc(int b, int& R, int& C) { const int st = b / 1024, sb = b % 1024, swz = sb ^ (((sb >> 9) & 1) << 5); R = (st >> 1) * 16 + swz / 64; C = (st & 1) * 32 + (swz % 64) / 2; }
__host__ __device__ __forceinline__ int perm32(int rho) { const int n = rho >> 4, i = rho & 15; return 8 * (i >> 2) + 4 * n + (i & 3); }
struct Unit { int pm, pn; };
struct Gemm { const bf16_t* A; const bf16_t* Bt; int M, N, K, lda, ldb; };
struct StaticOrder {
    int nM, nN, nwg, G, c;
    __host__ __device__ void init(int M, int N, int G_, int c_) { nM = M / BM; nN = N / BM; nwg = nM * nN; G = G_; c = c_; }
    __host__ __device__ bool next(int i, Unit& u) const {
        const long L = (long)i * G + c; if (L >= nwg) return false;
        int wgid = (int)L; { const int q = nwg / NXCD, r = nwg % NXCD, xcd = wgid % NXCD, off = wgid / NXCD; wgid = (xcd < r ? xcd * (q + 1) : r * (q + 1) + (xcd - r) * q) + off; }
        const int nig = WGM * nN, gid = wgid / nig, fm = gid * WGM, gsz = (nM - fm) < WGM ? (nM - fm) : WGM;
        u.pm = fm + ((wgid % nig) % gsz); u.pn = (wgid % nig) / gsz; return true;
    }
};
template <class Epi>
__device__ __forceinline__ void gemm_phase(LAS unsigned char* lds, const Gemm g, const StaticOrder& S, const Epi& E) {
    int tid = threadIdx.x; asm volatile("" : "+v"(tid));
    const int wid = __builtin_amdgcn_readfirstlane(tid >> 6), lane = tid & 63, wr = wid >> 2, wc = wid & 3, fr = lane & 15, fq = lane >> 4;
    const int K = g.K, nt = K / BK;
    unsigned voffA[2], voffB[2];
#pragma unroll
    for (int i = 0; i < 2; ++i) { int R, C; stage_rc(tid * 16 + i * 8192, R, C); const int Rb = Epi::PERM ? ((R & ~31) + perm32(R & 31)) : R;
        voffA[i] = (unsigned)(R * g.lda + C) * 2u; voffB[i] = (unsigned)(Rb * g.ldb + C) * 2u; }
    const size_t kstep = (size_t)(BK * 2);
    const size_t hstepA = (size_t)HALF * g.lda * 2, hstepB = (size_t)HALF * g.ldb * 2;
    const size_t tstepA = 2 * hstepA, tstepB = 2 * hstepB;
    const unsigned ldsw = (unsigned)wid * 1024u;
    const int aoff = lds_byte(wr * 64 + fr, fq * 8), boff = lds_byte(wc * 32 + fr, fq * 8);
#define PG8_SA(b, h) (((b) * 2 + (h)) * HTB)
#define PG8_SB(b, h) ((4 + (b) * 2 + (h)) * HTB)
#define PG8_STAGE(bufoff, gbase, voff) do { _Pragma("unroll") for (int _i = 0; _i < 2; ++_i) \
        __builtin_amdgcn_global_load_lds((const unsigned*)((const char*)(gbase) + (voff)[_i]), (LAS unsigned*)(lds + (bufoff) + ldsw + _i * 8192), 16, 0, 0); } while (0)
#define PG8_LDA(dst, b, h) do { _Pragma("unroll") for (int m = 0; m < 4; ++m) _Pragma("unroll") for (int k = 0; k < 2; ++k) dst[m][k] = *(const LAS bf16x8*)(lds + PG8_SA(b, h) + aoff + m * 2048 + k * 1024); } while (0)
#define PG8_LDB(dst, b, h) do { _Pragma("unroll") for (int n = 0; n < 2; ++n) _Pragma("unroll") for (int k = 0; k < 2; ++k) dst[n][k] = *(const LAS bf16x8*)(lds + PG8_SB(b, h) + boff + n * 2048 + k * 1024); } while (0)
#define PG8_MMA(ai, bj, At, Bt) do { __builtin_amdgcn_s_setprio(1); _Pragma("unroll") for (int m = 0; m < 4; ++m) _Pragma("unroll") for (int n = 0; n < 2; ++n) _Pragma("unroll") for (int k = 0; k < 2; ++k) \
        acc[ai][bj][m][n] = __builtin_amdgcn_mfma_f32_16x16x32_bf16(Bt[n][k], At[m][k], acc[ai][bj][m][n], 0, 0, 0); __builtin_amdgcn_s_setprio(0); } while (0)
#define PG8_WAIT_V(n) asm volatile("s_waitcnt vmcnt(" #n ")" ::: "memory")
#define PG8_WAIT_L(n) asm volatile("s_waitcnt lgkmcnt(" #n ")" ::: "memory")
#define PG8_BAR __builtin_amdgcn_s_barrier()
#define PG8_SCHED __builtin_amdgcn_sched_barrier(0)
    Unit cur, nxt; int ui = 0;
    if (!S.next(0, cur)) return;
    f32x4 acc[2][2][4][2];
#pragma unroll
    for (int a = 0; a < 2; ++a)
#pragma unroll
        for (int b = 0; b < 2; ++b)
#pragma unroll
            for (int m = 0; m < 4; ++m)
#pragma unroll
                for (int n = 0; n < 2; ++n) acc[a][b][m][n] = (f32x4){0.f, 0.f, 0.f, 0.f};
    bf16x8 At[4][2], B0[2][2], B1[2][2];
    const char* cA = (const char*)g.A + (size_t)cur.pm * tstepA; const char* cB = (const char*)g.Bt + (size_t)cur.pn * tstepB;
    PG8_STAGE(PG8_SB(0, 0), cB, voffB); PG8_STAGE(PG8_SB(0, 1), cB + hstepB, voffB); PG8_STAGE(PG8_SA(0, 0), cA, voffA); PG8_STAGE(PG8_SA(0, 1), cA + hstepA, voffA);
    if (wr == 1) PG8_BAR;
    PG8_WAIT_V(2); PG8_BAR;
    PG8_STAGE(PG8_SB(1, 0), cB + kstep, voffB); PG8_STAGE(PG8_SA(1, 0), cA + kstep, voffA); PG8_STAGE(PG8_SB(1, 1), cB + hstepB + kstep, voffB);
    PG8_WAIT_V(6); PG8_BAR;
    for (;;) {
        const bool has_next = S.next(ui + 1, nxt);
        const char* nA = has_next ? (const char*)g.A + (size_t)nxt.pm * tstepA : cA; const char* nB = has_next ? (const char*)g.Bt + (size_t)nxt.pn * tstepB : cB;
#pragma unroll 1
        for (int t = 0; t < nt; t += 2) {
            const bool last = (t == nt - 2);
            const char* a1 = cA + (size_t)(t + 1) * kstep;
            const char* a2 = last ? nA : cA + (size_t)(t + 2) * kstep; const char* b2 = last ? nB : cB + (size_t)(t + 2) * kstep;
            const char* a3 = a2 + kstep; const char* b3 = b2 + kstep;
            PG8_LDB(B0, 0, 0); PG8_LDB(B1, 0, 1); PG8_SCHED; PG8_LDA(At, 0, 0); PG8_STAGE(PG8_SA(1, 1), a1 + hstepA, voffA);
            PG8_WAIT_V(8); PG8_WAIT_L(0); PG8_BAR; PG8_MMA(0, 0, At, B0); PG8_MMA(0, 1, At, B1); PG8_BAR; PG8_SCHED;
            PG8_LDA(At, 0, 1); PG8_STAGE(PG8_SB(0, 0), b2, voffB); PG8_STAGE(PG8_SB(0, 1), b2 + hstepB, voffB); PG8_STAGE(PG8_SA(0, 0), a2, voffA);
            PG8_WAIT_V(8); PG8_WAIT_L(0); PG8_BAR; PG8_MMA(1, 0, At, B0); PG8_MMA(1, 1, At, B1); PG8_BAR; PG8_SCHED;
            PG8_LDB(B0, 1, 0); PG8_LDB(B1, 1, 1); PG8_SCHED; PG8_LDA(At, 1, 0); PG8_STAGE(PG8_SA(0, 1), a2 + hstepA, voffA);
            PG8_WAIT_V(8); PG8_WAIT_L(0); PG8_BAR; PG8_MMA(0, 0, At, B0); PG8_MMA(0, 1, At, B1); PG8_BAR; PG8_SCHED;
            PG8_LDA(At, 1, 1); PG8_STAGE(PG8_SB(1, 0), b3, voffB); PG8_STAGE(PG8_SB(1, 1), b3 + hstepB, voffB); PG8_STAGE(PG8_SA(1, 0), a3, voffA);
            PG8_WAIT_V(8); PG8_WAIT_L(0); PG8_BAR; PG8_MMA(1, 0, At, B0); PG8_MMA(1, 1, At, B1); PG8_BAR; PG8_SCHED;
        }
        if (wr == 0) PG8_BAR;
        { int fr2 = fr, fq2 = fq; asm volatile("" : "+v"(fr2), "+v"(fq2)); E(acc, cur, wr, wc, fr2, fq2); }
        if (!has_next) break;
#pragma unroll
        for (int a = 0; a < 2; ++a)
#pragma unroll
            for (int b = 0; b < 2; ++b)
#pragma unroll
                for (int m = 0; m < 4; ++m)
#pragma unroll
                    for (int n = 0; n < 2; ++n) acc[a][b][m][n] = (f32x4){0.f, 0.f, 0.f, 0.f};
        cur = nxt; cA = nA; cB = nB; ++ui;
        if (wr == 1) PG8_BAR;
    }
    PG8_WAIT_V(0);
    PG8_BAR;
#undef PG8_SA
#undef PG8_SB
#undef PG8_STAGE
#undef PG8_LDA
#undef PG8_LDB
#undef PG8_MMA
#undef PG8_WAIT_V
#undef PG8_WAIT_L
#undef PG8_BAR
#undef PG8_SCHED
}

DI f32x2 gelu_pk(f32x2 v) {
    const f32x2 av = __builtin_elementwise_abs(v), d = av * 0.2316418882f + 1.0f;
    f32x2 t; t.x = __builtin_amdgcn_rcpf(d.x); t.y = __builtin_amdgcn_rcpf(d.y);
    f32x2 q = t * 0.5307027145f + (-0.7265760135f); q = q * t + 0.7107068705f; q = q * t + (-0.142248368f); q = q * t + 0.127414796f; q = q * t;
    const f32x2 s = (v * v) * (-0.72134752044f);
    f32x2 e; e.x = __builtin_amdgcn_exp2f(s.x); e.y = __builtin_amdgcn_exp2f(s.y);
    const f32x2 m = v * (q * e), r = v - m;
    f32x2 o; o.x = v.x < 0.f ? m.x : r.x; o.y = v.y < 0.f ? m.y : r.y; return o;
}
struct EpiBf16 {
    static constexpr bool PERM = true;
    bf16_t* O1; int ld1; bf16_t* O2; int ld2; int split_pn;
    DI void operator()(const f32x4 (&acc)[2][2][4][2], const Unit& u, int wr, int wc, int fr, int fq) const {
        const int row0 = u.pm * BM + wr * 64 + fr;
        bf16_t* base; int ld, colt;
        if (u.pn < split_pn) { base = O1; ld = ld1; colt = u.pn * BM; } else { base = O2; ld = ld2; colt = (u.pn - split_pn) * BM; }
        const int col0 = colt + wc * 32 + 8 * fq;
#pragma unroll
        for (int ai = 0; ai < 2; ++ai)
#pragma unroll
            for (int m = 0; m < 4; ++m) { bf16_t* rowp = base + (size_t)(row0 + ai * HALF + m * 16) * ld + col0;
#pragma unroll
                for (int bj = 0; bj < 2; ++bj) { const f32x4 v0 = acc[ai][bj][m][0], v1 = acc[ai][bj][m][1];
                    u32x4 w; w.x = pk2(v0[0], v0[1]); w.y = pk2(v0[2], v0[3]); w.z = pk2(v1[0], v1[1]); w.w = pk2(v1[2], v1[3]);
                    *(u32x4*)(rowp + bj * HALF) = w; } }
    }
};
struct EpiSwiGLU {
    static constexpr bool PERM = true;
    bf16_t* O; int ldc;
    DI void operator()(const f32x4 (&acc)[2][2][4][2], const Unit& u, int wr, int wc, int fr, int fq) const {
        const int row0 = u.pm * BM + wr * 64 + fr, col0 = u.pn * HALF + wc * 32 + 8 * fq;
#pragma unroll
        for (int ai = 0; ai < 2; ++ai)
#pragma unroll
            for (int m = 0; m < 4; ++m) { bf16_t* rowp = O + (size_t)(row0 + ai * HALF + m * 16) * ldc + col0;
                float o[8];
#pragma unroll
                for (int n = 0; n < 2; ++n)
#pragma unroll
                    for (int j = 0; j < 4; ++j) o[n * 4 + j] = silu_f(acc[ai][0][m][n][j]) * acc[ai][1][m][n][j];
                u32x4 w; w.x = pk2(o[0], o[1]); w.y = pk2(o[2], o[3]); w.z = pk2(o[4], o[5]); w.w = pk2(o[6], o[7]);
                *(u32x4*)rowp = w; }
    }
};
template <bool HALFS> struct EpiResid {
    static constexpr bool PERM = false; static constexpr float scale = HALFS ? 0.5f : 1.0f;
    const float* zprev; const float* mur; const float* lng; const float* lnb;
    const float* gate;
    float* zout; float* pst;
    DI void operator()(const f32x4 (&acc)[2][2][4][2], const Unit& u, int wr, int wc, int fr, int fq) const {
        const int row0 = u.pm * BM + wr * 64 + fr, col0 = u.pn * BM + wc * 32 + 4 * fq, lane = fr | (fq << 4);
        const float* gt = gate + (size_t)((u.pm * BM) / SEQ) * 9216;
#pragma unroll
        for (int ai = 0; ai < 2; ++ai)
#pragma unroll
            for (int m = 0; m < 4; ++m) { const int row = row0 + ai * HALF + m * 16; const size_t off = (size_t)row * DM + col0;
                float mu = 0.f, rs = 1.f; if (mur) { const f32x2 mr = *(const f32x2*)(mur + 2 * row); mu = mr.x; rs = mr.y; }
                float s = 0.f, q = 0.f;
#pragma unroll
                for (int bj = 0; bj < 2; ++bj)
#pragma unroll
                    for (int n = 0; n < 2; ++n) { const int co = bj * HALF + n * 16;
                        f32x4 xr = *(const f32x4*)(zprev + off + co);
                        if (mur) { const f32x4 g4 = *(const f32x4*)(lng + col0 + co), b4 = *(const f32x4*)(lnb + col0 + co); xr = (xr - mu) * rs * g4 + b4; }
                        const f32x4 g1 = *(const f32x4*)(gt + col0 + co);
                        const f32x4 z = xr * DN_ALPHA + (g1 + 1.0f) * (acc[ai][bj][m][n] * scale);
                        *(f32x4*)(zout + off + co) = z;
                        s += (z[0] + z[1]) + (z[2] + z[3]); q += (z[0] * z[0] + z[1] * z[1]) + (z[2] * z[2] + z[3] * z[3]); }
                s += shx(s, 16, lane); s += shx(s, 32, lane); q += shx(q, 16, lane); q += shx(q, 32, lane);
                if (fq == 0) *(f32x2*)(pst + (size_t)row * 32 + (u.pn * 4 + wc) * 2) = (f32x2){s, q};
                asm volatile("" ::: "memory"); }
    }
};
struct EpiQRope {
    static constexpr bool PERM = true;
    bf16_t* Q; const float* rc; const float* rs;
    DI void operator()(const f32x4 (&acc)[2][2][4][2], const Unit& u, int wr, int wc, int fr, int fq) const {
        const int row0 = u.pm * BM + wr * 64 + fr;
        if (u.pn < 4) {
#pragma unroll
            for (int ai = 0; ai < 2; ++ai)
#pragma unroll
                for (int m = 0; m < 4; ++m) { bf16_t* rowp = Q + (size_t)(row0 + ai * HALF + m * 16) * 1536 + wc * 32 + 8 * fq;
#pragma unroll
                    for (int bj = 0; bj < 2; ++bj) { const f32x4 v0 = acc[ai][bj][m][0] * QSCALE, v1 = acc[ai][bj][m][1] * QSCALE;
                        u32x4 w; w.x = pk2(v0[0], v0[1]); w.y = pk2(v0[2], v0[3]); w.z = pk2(v1[0], v1[1]); w.w = pk2(v1[2], v1[3]);
                        *(u32x4*)(rowp + (2 * u.pn + bj) * 192) = w; } }
        } else {
            const int head = 4 * (u.pn - 4) + wc;
#pragma unroll
            for (int ai = 0; ai < 2; ++ai)
#pragma unroll
                for (int m = 0; m < 4; ++m) { const int row = row0 + ai * HALF + m * 16; const int pos = row & (SEQ - 1);
                    bf16_t* rowp = Q + (size_t)row * 1536 + head * 192 + 128 + 8 * fq;
#pragma unroll
                    for (int n = 0; n < 2; ++n) { const f32x4 c4 = *(const f32x4*)(rc + pos * 32 + 8 * fq + 4 * n), s4 = *(const f32x4*)(rs + pos * 32 + 8 * fq + 4 * n);
                        const f32x4 x1 = acc[ai][0][m][n], x2 = acc[ai][1][m][n];
                        const f32x4 a = (x1 * c4 - x2 * s4) * QSCALE, b = (x2 * c4 + x1 * s4) * QSCALE;
                        *(u32x2*)(rowp + 4 * n) = (u32x2){pk2(a[0], a[1]), pk2(a[2], a[3])};
                        *(u32x2*)(rowp + 32 + 4 * n) = (u32x2){pk2(b[0], b[1]), pk2(b[2], b[3])}; }
                    asm volatile("" ::: "memory"); }
        }
    }
};
struct EpiGeluUV {
    static constexpr bool PERM = true;
    bf16_t* O; const float* bias; float* vst;
    DI void operator()(const f32x4 (&acc)[2][2][4][2], const Unit& u, int wr, int wc, int fr, int fq) const {
        const int row0 = u.pm * BM + wr * 64 + fr, col0 = u.pn * BM + wc * 32 + 8 * fq, lane = fr | (fq << 4);
#pragma unroll
        for (int ai = 0; ai < 2; ++ai)
#pragma unroll
            for (int m = 0; m < 4; ++m) { const int row = row0 + ai * HALF + m * 16; bf16_t* rowp = O + (size_t)row * 4096 + col0;
                float s = 0.f, q = 0.f;
#pragma unroll
                for (int bj = 0; bj < 2; ++bj) {
                    const f32x4 b0 = *(const f32x4*)(bias + col0 + bj * HALF), b1 = *(const f32x4*)(bias + col0 + bj * HALF + 4);
                    const f32x4 v0 = acc[ai][bj][m][0] + b0, v1 = acc[ai][bj][m][1] + b1;
                    const f32x2 a = gelu_pk((f32x2){v0[0], v0[1]}), b = gelu_pk((f32x2){v0[2], v0[3]}), c = gelu_pk((f32x2){v1[0], v1[1]}), d = gelu_pk((f32x2){v1[2], v1[3]});
                    u32x4 w; w.x = pk2(a.x, a.y); w.y = pk2(b.x, b.y); w.z = pk2(c.x, c.y); w.w = pk2(d.x, d.y);
                    *(u32x4*)(rowp + bj * HALF) = w;
                    s += (a.x + a.y) + (b.x + b.y) + (c.x + c.y) + (d.x + d.y);
                    q += (a.x * a.x + a.y * a.y) + (b.x * b.x + b.y * b.y) + (c.x * c.x + c.y * c.y) + (d.x * d.x + d.y * d.y); }
                if (u.pn >= 8) { s += shx(s, 16, lane); s += shx(s, 32, lane); q += shx(q, 16, lane); q += shx(q, 32, lane);
                    if (fq == 0) *(f32x2*)(vst + (size_t)row * 64 + ((u.pn - 8) * 4 + wc) * 2) = (f32x2){s, q}; }
                asm volatile("" ::: "memory"); }
    }
};
}

DI int cvt_src(int mode, int nb) {
    if (mode == 1) { return ((nb >> 2) & 1) * DFF + 128 * (nb >> 3) + 32 * (nb & 3); }
    if (mode == 2) { const int t = nb >> 3, half = (nb >> 2) & 1, q = nb & 3;
        return t < 4 ? (2 * t + half) * 192 + 32 * q : (4 * (t - 4) + q) * 192 + 128 + 32 * half; }
    if (mode == 3) { return (nb >> 2) * 256 + 32 * (nb & 3); }
    if (mode == 4) { return (nb >> 2) * 256 + 128 + 32 * (nb & 3); }
    return 32 * nb;
}
DI void cvt_job(const float* W, int K, int N, bf16_t* Wt, int Nout, int mode, LAS float* scr, int gw, int ngw, int lane) {
    const int nblk = Nout / 32, nitems = (K / 64) * nblk;
    for (int it = gw; it < nitems; it += ngw) {
        const int kb = it / nblk, nb = it % nblk, k0 = 64 * kb, n0 = 32 * nb;
        const int sc = cvt_src(mode, nb) + (lane & 31); const bool ok = sc < N;
#pragma unroll 8
        for (int i = 0; i < 32; ++i) { const int kk = 2 * i + (lane >> 5); scr[kk * 33 + (lane & 31)] = ok ? W[(size_t)(k0 + kk) * N + sc] : 0.f; }
        asm volatile("s_waitcnt lgkmcnt(0)" ::: "memory");
        const int c = lane & 7;
#pragma unroll
        for (int j = 0; j < 4; ++j) { const int n = (lane >> 3) + 8 * j; const LAS float* s = scr + (8 * c) * 33 + n;
            u32x4 o; o.x = pk2(s[0 * 33], s[1 * 33]); o.y = pk2(s[2 * 33], s[3 * 33]); o.z = pk2(s[4 * 33], s[5 * 33]); o.w = pk2(s[6 * 33], s[7 * 33]);
            *(u32x4*)(Wt + (size_t)(n0 + n) * K + k0 + 8 * c) = o; }
        asm volatile("s_waitcnt lgkmcnt(0)" ::: "memory");
    }
}

DI void normmod_f(const float* zin, bool has_ln, const float* lng, const float* lnb, const float* mods_l, int ksh, int ksc, const float* PST, float* MUR, bf16_t* HMOD, int gw, int ngw, int lane) {
    for (int m0 = gw * 4; m0 < MT; m0 += ngw * 4) {
        f32x4 x[4][4]; float mu[4], rs[4]; f32x2 p[4];
#pragma unroll
        for (int r = 0; r < 4; ++r) { p[r] = (f32x2){0.f, 0.f}; if (has_ln && lane < 16) p[r] = *(const f32x2*)(PST + (size_t)(m0 + r) * 32 + lane * 2); }
#pragma unroll
        for (int r = 0; r < 4; ++r)
#pragma unroll
            for (int j = 0; j < 4; ++j) x[r][j] = *(const f32x4*)(zin + (size_t)(m0 + r) * DM + 4 * lane + 256 * j);
#pragma unroll
        for (int r = 0; r < 4; ++r) { mu[r] = 0.f; rs[r] = 1.f;
            if (has_ln) { float s = p[r].x, q = p[r].y;
#pragma unroll
                for (int o = 1; o < 16; o <<= 1) { s += shx(s, o, lane); q += shx(q, o, lane); }
                s = rdl(s, 0); q = rdl(q, 0); mu[r] = s * (1.f / DM); rs[r] = rsqrtf(fmaxf(q * (1.f / DM) - mu[r] * mu[r], 0.f) + LN_EPS);
                if (lane == 0) *(f32x2*)(MUR + 2 * (m0 + r)) = (f32x2){mu[r], rs[r]}; } }
        const float* mb = mods_l + (size_t)(m0 / SEQ) * 9216;
#pragma unroll
        for (int j = 0; j < 4; ++j) { const int col = 4 * lane + 256 * j;
            const f32x4 sc1 = *(const f32x4*)(mb + ksc * DM + col) + 1.0f, sh = *(const f32x4*)(mb + ksh * DM + col);
            f32x4 g4 = (f32x4){1.f, 1.f, 1.f, 1.f}, b4 = (f32x4){0.f, 0.f, 0.f, 0.f};
            if (has_ln) { g4 = *(const f32x4*)(lng + col); b4 = *(const f32x4*)(lnb + col); }
#pragma unroll
            for (int r = 0; r < 4; ++r) { f32x4 xx = x[r][j]; if (has_ln) xx = (xx - mu[r]) * rs[r] * g4 + b4;
                const f32x4 h = xx * sc1 + sh;
                *(u32x2*)(HMOD + (size_t)(m0 + r) * DM + col) = (u32x2){pk2(h[0], h[1]), pk2(h[2], h[3])}; } }
    }
}

typedef const float* __attribute__((address_space(4))) KPTR_unused;
typedef const float* KPTR_t; typedef __attribute__((address_space(4))) KPTR_t KPTR;
#define IN(i) (kin[i])
struct KArgs { const float* in[37]; float* out; unsigned char* ws; int ph_lo, ph_hi; };

enum { I_X = 0, I_C = 1, I_L0 = 2, I_WIN = 10, I_CONVW = 11, I_CONVB = 12, I_DTB = 13, I_ALOG = 14, I_DSKIP = 15, I_SSDNW = 16, I_QNW = 17, I_WUQ = 18, I_KVNW = 19, I_WUKV = 20, I_WOUT0 = 21,
       I_L1 = 22, I_WUV = 30, I_BUV = 31, I_SLNG = 32, I_SLNB = 33, I_WS = 34, I_BS = 35, I_WOUT1 = 36 };

#define MODS ((float*)(ws + WS_MODS))
#define ROPEC ((float*)(ws + WS_ROPEC))
#define ROPES ((float*)(ws + WS_ROPES))
#define PST ((float*)(ws + WS_PST))
#define MUR ((float*)(ws + WS_MUR))
#define HMOD ((bf16_t*)(ws + WS_HMOD))
#define ZA ((float*)(ws + WS_ZA))
#define ACT ((bf16_t*)(ws + WS_ACT))
#define FFIN ((bf16_t*)(ws + WS_FFIN))
#define FFOUT ((bf16_t*)(ws + WS_FFOUT))
#ifndef PROBE_DUP
#define PROBE_DUP 0u
#endif
#define PHASE_BEGIN if (ph >= a.ph_lo && ph < a.ph_hi) for (int rep_ = 0; rep_ <= (int)((PROBE_DUP >> ph) & 1u); ++rep_) { int tid = threadIdx.x; asm volatile("" : "+v"(tid)); int bid = blockIdx.x; asm volatile("" : "+s"(bid)); int G = gridDim.x; asm volatile("" : "+s"(G)); const int ngw = G * 8; (void)ngw; const int lane = tid & 63, wave = __builtin_amdgcn_readfirstlane(tid >> 6), gw = bid * 8 + wave; (void)lane; (void)gw; \
    int zo_ = 0; asm volatile("" : "+s"(zo_)); const KPTR* kin = (const KPTR*)__builtin_amdgcn_kernarg_segment_ptr() + zo_; unsigned char* ws = (unsigned char*)kin[38]; float* dout = (float*)kin[37]; (void)ws; (void)dout;
#define PHASE_END   if (ph + 1 < a.ph_hi || rep_ < (int)((PROBE_DUP >> ph) & 1u)) grid.sync(); else __syncthreads(); } ++ph;

#define CVT(src, K_, N_, dst, Nout_, mode_) cvt_job(IN(src), K_, N_, (bf16_t*)(ws + (dst)), Nout_, mode_, (LAS float*)(L + wave * 16384), gw, ngw, lane)

#define normmod(zin, has_ln, lng_, lnb_, mods_, ksh, ksc) normmod_f(zin, has_ln, lng_, lnb_, mods_, ksh, ksc, PST, MUR, HMOD, gw, ngw, lane)
#define gemm_ffin() do { pg8::Gemm g{HMOD, FFIN, MT, 2 * DFF, DM, DM, DM}; pg8::StaticOrder S; S.init(MT, 2 * DFF, G, bid); pg8::EpiSwiGLU E{ACT, DFF}; pg8::gemm_phase(L, g, S, E); } while (0)
#define gemm_resid(A_, K_, Wt_, zprev_, has_ln_, lng_, lnb_, gate_, scale_, zout_) do { pg8::Gemm g{A_, Wt_, MT, DM, K_, K_, K_}; pg8::StaticOrder S; S.init(MT, DM, G, bid); \
        pg8::EpiResid<(scale_) < 0.75f> E{zprev_, (has_ln_) ? MUR : nullptr, lng_, lnb_, gate_, zout_, PST}; pg8::gemm_phase(L, g, S, E); } while (0)

template <int layer>
DI void layer_body(const KArgs& a, LAS unsigned char* L, int& ph, cg::grid_group& grid) {
        const int IL = layer ? I_L1 : I_L0;
#define mods_l (MODS + (size_t)layer * 8 * 9216)
#define lng IN(IL + 2)
#define lnb IN(IL + 3)
#define lngp (IN(I_L0 + 2) + 2 * DM)
#define lnbp (IN(I_L0 + 3) + 2 * DM)
#define zin0 (layer ? (const float*)ZA : (const float*)IN(I_X))
#define bufA (layer ? dout : ZA)
#define bufB (layer ? ZA : dout)
        PHASE_BEGIN
            normmod(zin0, layer == 1, lngp, lnbp, mods_l, 0, 1);
            if (layer == 1) {
                CVT(I_L1 + 4, DM, 2 * DFF, WS_FFIN, 2 * DFF, 1);
                CVT(I_L1 + 5, DFF, DM, WS_FFOUT, DM, 0);
                CVT(I_WUV, DM, 4096, WS_WUV1, 4096, 0);
                CVT(I_WOUT1, 2048, DM, WS_WOUT1, DM, 0);
                {
                    for (int i = bid * 512 + tid; i < 16 * 128 * 128 / 4; i += G * 512) { const int e = i * 4, t = (e >> 7) & 127, s0 = e & 127;
                        const f32x4 v = *(const f32x4*)(IN(I_WS) + e);
                        *(u32x2*)(((bf16_t*)(ws + WS_WSB)) + e) = (u32x2){pk2(s0 <= t ? v[0] : 0.f, s0 + 1 <= t ? v[1] : 0.f), pk2(s0 + 2 <= t ? v[2] : 0.f, s0 + 3 <= t ? v[3] : 0.f)}; }
                }
            }
        PHASE_END
        PHASE_BEGIN gemm_ffin(); PHASE_END
        PHASE_BEGIN gemm_resid(ACT, DFF, FFOUT, zin0, layer == 1, lngp, lnbp, mods_l + 2 * DM, 0.5f, bufA); PHASE_END
        PHASE_BEGIN
            normmod(bufA, true, lng, lnb, mods_l, 3, 4);
            CVT(IL + 6, DM, 2 * DFF, WS_FFIN, 2 * DFF, 1);
            CVT(IL + 7, DFF, DM, WS_FFOUT, DM, 0);
        PHASE_END
        if (layer == 0) {
#define ZG ((bf16_t*)(ws + WS_ZG))
#define PROJ2 ((bf16_t*)(ws + WS_PROJ2))
#define XT ((bf16_t*)(ws + WS_XT))
#define BT ((bf16_t*)(ws + WS_BT))
#define BN ((bf16_t*)(ws + WS_BN))
#define CN ((bf16_t*)(ws + WS_CN))
#define DT ((float*)(ws + WS_DT))
#define CS ((float*)(ws + WS_CS))
#define CKVN ((bf16_t*)(ws + WS_CKVN))
#define YCAT ((bf16_t*)(ws + WS_YCAT))
#define KN ((bf16_t*)(ws + WS_KN))
#define VT ((bf16_t*)(ws + WS_VT))
#define Q ((bf16_t*)((char*)dout + DO_Q))
#define CQN ((bf16_t*)((char*)dout + DO_CQN))
#define KPE ((bf16_t*)((char*)dout + DO_KPE))
#define SSQ ((float*)((char*)dout + DO_SSQ))
            PHASE_BEGIN
                pg8::Gemm g{HMOD, (bf16_t*)(ws + WS_WIN), MT, 3328, DM, DM, DM}; pg8::StaticOrder S; S.init(MT, 3328, G, bid);
                pg8::EpiBf16 E{ZG, 1024, PROJ2, 2304, 4}; pg8::gemm_phase(L, g, S, E);
            PHASE_END
            PHASE_BEGIN
                {
                    LAS bf16_t* tin = (LAS bf16_t*)L;
                    for (int u = bid; u < 128 * 24; u += G) {
                        const int tb = u / 24, cb = u % 24, t0 = tb * 128, c0 = cb * 64;
                        __syncthreads();
                        for (int i = tid; i < 131 * 8; i += 512) { const int rr = i >> 3, ch8 = (i & 7) * 8; const int tok = t0 - 3 + rr;
                            u32x4 v = (u32x4){0u, 0u, 0u, 0u};
                            if (!((t0 & (SEQ - 1)) == 0 && rr < 3)) v = *(const u32x4*)(PROJ2 + (size_t)tok * 2304 + c0 + ch8);
                            *(LAS u32x4*)(tin + rr * 64 + ch8) = v; }
                        __syncthreads();
                        const int ch = tid & 63, seg = tid >> 6, cg_ = c0 + ch;
                        const float w0 = IN(I_CONVW)[cg_], w1 = IN(I_CONVW)[1536 + cg_], w2 = IN(I_CONVW)[2 * 1536 + cg_], w3 = IN(I_CONVW)[3 * 1536 + cg_], cbias = IN(I_CONVB)[cg_];
                        float iv[19];
#pragma unroll
                        for (int i = 0; i < 19; ++i) iv[i] = bf1(tin[(seg * 16 + i) * 64 + ch]);
                        float o[16];
#pragma unroll
                        for (int i = 0; i < 16; ++i) o[i] = silu_f(cbias + w0 * iv[i] + w1 * iv[i + 1] + w2 * iv[i + 2] + w3 * iv[i + 3]);
                        const int bb = t0 / SEQ, s0 = (t0 & (SEQ - 1)) + seg * 16;
                        u32x4 p0, p1; p0.x = pk2(o[0], o[1]); p0.y = pk2(o[2], o[3]); p0.z = pk2(o[4], o[5]); p0.w = pk2(o[6], o[7]);
                        p1.x = pk2(o[8], o[9]); p1.y = pk2(o[10], o[11]); p1.z = pk2(o[12], o[13]); p1.w = pk2(o[14], o[15]);
                        if (cg_ < 1024) { bf16_t* d = XT + ((size_t)bb * 1024 + cg_) * SEQ + s0; *(u32x4*)d = p0; *(u32x4*)(d + 8) = p1; }
                        else if (cg_ < 1280) { const int n = cg_ - 1024; bf16_t* d = BT + ((size_t)bb * 256 + n) * SEQ + s0; *(u32x4*)d = p0; *(u32x4*)(d + 8) = p1;
#pragma unroll
                            for (int i = 0; i < 16; ++i) BN[(size_t)(t0 + seg * 16 + i) * 256 + n] = tobf(o[i]); }
                        else { const int n = cg_ - 1280;
#pragma unroll
                            for (int i = 0; i < 16; ++i) CN[(size_t)(t0 + seg * 16 + i) * 256 + n] = tobf(o[i]); }
                    }
                    __syncthreads();
                }
                {
                    LAS float* dtl = (LAS float*)(L + 32768);
                    for (int u = bid; u < 128; u += G) {
                        __syncthreads();
                        for (int i = tid; i < 2048; i += 512) { const int tk = i >> 4, h = i & 15;
                            const float x = bf1(PROJ2[(size_t)(u * 128 + tk) * 2304 + 1536 + h]) + IN(I_DTB)[h];
                            dtl[i] = fmaxf(x, 0.f) + log1pf(__expf(-fabsf(x))); }
                        __syncthreads();
                        if (tid < 16) { const int h = tid, bb = u >> 4, s0 = (u & 15) * 128; const float av = -__expf(IN(I_ALOG)[h]); float cs = 0.f;
                            float* dp = DT + ((size_t)bb * 16 + h) * SEQ + s0; float* cp = CS + ((size_t)bb * 16 + h) * SEQ + s0;
                            for (int t = 0; t < 128; ++t) { const float d = dtl[t * 16 + h]; cs += d * av; dp[t] = d; cp[t] = cs; } }
                    }
                    __syncthreads();
                }
                for (int m = gw; m < MT; m += ngw) {
                    const bf16_t* pr = PROJ2 + (size_t)m * 2304;
                    float x[6]; float s = 0.f;
#pragma unroll
                    for (int j = 0; j < 3; ++j) { const unsigned v = *(const unsigned*)(pr + 1552 + 2 * lane + 128 * j); x[2 * j] = bflo(v); x[2 * j + 1] = bfhi(v); s += x[2 * j] * x[2 * j] + x[2 * j + 1] * x[2 * j + 1]; }
                    float rs = rsqrtf(wave_sum(s, lane) * (1.f / 384.f) + LN_EPS);
#pragma unroll
                    for (int j = 0; j < 3; ++j) { const int e = 2 * lane + 128 * j; *(unsigned*)(CQN + (size_t)m * 384 + e) = pk2(x[2 * j] * rs * IN(I_QNW)[e], x[2 * j + 1] * rs * IN(I_QNW)[e + 1]); }
                    const u32x2 kv = *(const u32x2*)(pr + 1936 + 4 * lane);
                    const float k0 = bflo(kv.x), k1 = bfhi(kv.x), k2 = bflo(kv.y), k3 = bfhi(kv.y);
                    rs = rsqrtf(wave_sum(k0 * k0 + k1 * k1 + k2 * k2 + k3 * k3, lane) * (1.f / 256.f) + LN_EPS);
                    const f32x4 kw = *(const f32x4*)(IN(I_KVNW) + 4 * lane);
                    *(u32x2*)(CKVN + (size_t)m * 256 + 4 * lane) = (u32x2){pk2(k0 * rs * kw[0], k1 * rs * kw[1]), pk2(k2 * rs * kw[2], k3 * rs * kw[3])};
                    if (lane < 32) { const int pos = m & (SEQ - 1); const float x1 = bf1(pr[2192 + lane]), x2 = bf1(pr[2192 + 32 + lane]);
                        const float c = ROPEC[pos * 32 + lane], sn = ROPES[pos * 32 + lane];
                        KPE[(size_t)m * 64 + lane] = tobf(x1 * c - x2 * sn); KPE[(size_t)m * 64 + 32 + lane] = tobf(x2 * c + x1 * sn); }
                }
            PHASE_END
            PHASE_BEGIN
                { pg8::Gemm g{CQN, (bf16_t*)(ws + WS_WUQ), MT, 1536, 384, 384, 384}; pg8::StaticOrder S; S.init(MT, 1536, G, bid);
                  pg8::EpiQRope E{Q, ROPEC, ROPES}; pg8::gemm_phase(L, g, S, E); }
                { pg8::Gemm g{CKVN, (bf16_t*)(ws + WS_WUK), MT, 1024, 256, 256, 256}; pg8::StaticOrder S; S.init(MT, 1024, G, bid);
                  pg8::EpiBf16 E{KN, 1024, KN, 1024, 0}; pg8::gemm_phase(L, g, S, E); }
                { pg8::Gemm g{(bf16_t*)(ws + WS_WUV0), CKVN, 1024, MT, 256, 256, 256}; pg8::StaticOrder S; S.init(1024, MT, G, bid);
                  pg8::EpiBf16 E{VT, MT, VT, MT, 0}; pg8::gemm_phase(L, g, S, E); }
            PHASE_END
            PHASE_BEGIN
                const int r = lane & 31, hh = lane >> 5;
#ifndef NO_SSD
                if (bid < 128) {
                    constexpr int BL = 0, CL = 34816, WL = 69632, XL = 104448, SL = 121856, DTL = 139264, CSL = 139776, RS = 272;
                    const int b = bid >> 4, hd = bid & 15, g = hd >> 3, pb = wave >> 2, qb = wave & 3;
                    const float dskip = IN(I_DSKIP)[hd];
                    const float* dtp = DT + ((size_t)b * 16 + hd) * SEQ; const float* csp = CS + ((size_t)b * 16 + hd) * SEQ;
                    f32x16 st = zero16();
                    for (int c = 0; c < 16; ++c) {
                        const int t0 = c * 128; const size_t tokb = (size_t)b * SEQ + t0;
                        __syncthreads();
                        if (tid < 128) ((LAS float*)(L + DTL))[tid] = dtp[t0 + tid];
                        else if (tid < 256) ((LAS float*)(L + CSL))[tid - 128] = csp[t0 + tid - 128];
                        const float cse = csp[t0 + 127];
#pragma unroll
                        for (int i = 0; i < 4; ++i) { const int ci = tid + 512 * i, row = ci >> 4, ch = ci & 15;
                            *(LAS u32x4*)(L + BL + row * RS + ch * 16) = *(const u32x4*)(BN + (tokb + row) * 256 + g * 128 + ch * 8);
                            *(LAS u32x4*)(L + CL + row * RS + ch * 16) = *(const u32x4*)(CN + (tokb + row) * 256 + g * 128 + ch * 8);
                            const u32x4 bt = *(const u32x4*)(BT + ((size_t)b * 256 + g * 128 + row) * SEQ + t0 + ch * 8);
                            const f32x4 d0 = *(const f32x4*)(dtp + t0 + ch * 8), d1 = *(const f32x4*)(dtp + t0 + ch * 8 + 4);
                            const f32x4 c0 = *(const f32x4*)(csp + t0 + ch * 8), c1 = *(const f32x4*)(csp + t0 + ch * 8 + 4);
                            u32x4 o;
                            o.x = pk2(bflo(bt.x) * d0[0] * __expf(cse - c0[0]), bfhi(bt.x) * d0[1] * __expf(cse - c0[1]));
                            o.y = pk2(bflo(bt.y) * d0[2] * __expf(cse - c0[2]), bfhi(bt.y) * d0[3] * __expf(cse - c0[3]));
                            o.z = pk2(bflo(bt.z) * d1[0] * __expf(cse - c1[0]), bfhi(bt.z) * d1[1] * __expf(cse - c1[1]));
                            o.w = pk2(bflo(bt.w) * d1[2] * __expf(cse - c1[2]), bfhi(bt.w) * d1[3] * __expf(cse - c1[3]));
                            *(LAS u32x4*)(L + WL + row * RS + ch * 16) = o; }
#pragma unroll
                        for (int i = 0; i < 2; ++i) { const int ci = tid + 512 * i, p = ci >> 4, ch = ci & 15;
                            *(LAS u32x4*)(L + XL + p * RS + ch * 16) = *(const u32x4*)(XT + ((size_t)b * 1024 + hd * 64 + p) * SEQ + t0 + ch * 8); }
#pragma unroll
                        for (int i = 0; i < 16; ++i) *(LAS bf16_t*)(L + SL + (32 * pb + crow(i, hh)) * RS + (32 * qb + r) * 2) = tobf(st[i]);
                        __syncthreads();
                        const LAS float* dtl = (const LAS float*)(L + DTL); const LAS float* csl = (const LAS float*)(L + CSL);
                        const int lb = qb, l = 32 * lb + r; const float csL = csl[l];
                        f32x16 y = zero16();
#pragma unroll
                        for (int ks = 0; ks < 8; ++ks) y = mfma32(*(const LAS bf16x8*)(L + SL + (32 * pb + r) * RS + (16 * ks + 8 * hh) * 2), *(const LAS bf16x8*)(L + CL + l * RS + (16 * ks + 8 * hh) * 2), y);
                        { const float e = __expf(csL);
#pragma unroll
                          for (int i = 0; i < 16; ++i) y[i] *= e; }
                        for (int sb = 0; sb <= lb; ++sb) {
                            f32x16 cb = zero16();
#pragma unroll
                            for (int ks = 0; ks < 8; ++ks) cb = mfma32(*(const LAS bf16x8*)(L + BL + (32 * sb + r) * RS + (16 * ks + 8 * hh) * 2), *(const LAS bf16x8*)(L + CL + l * RS + (16 * ks + 8 * hh) * 2), cb);
#pragma unroll
                            for (int i = 0; i < 16; ++i) { const int s = 32 * sb + crow(i, hh); cb[i] = (s <= l) ? cb[i] * __expf(csL - csl[s]) * dtl[s] : 0.f; }
#pragma unroll
                            for (int s2 = 0; s2 < 2; ++s2) {
                                u32x4 pf; pf.x = pk2(cb[8 * s2], cb[8 * s2 + 1]); pf.y = pk2(cb[8 * s2 + 2], cb[8 * s2 + 3]); pf.z = pk2(cb[8 * s2 + 4], cb[8 * s2 + 5]); pf.w = pk2(cb[8 * s2 + 6], cb[8 * s2 + 7]);
                                const LAS unsigned char* xp = L + XL + (32 * pb + r) * RS + (32 * sb + 16 * s2 + 4 * hh) * 2;
                                const u32x2 x0 = *(const LAS u32x2*)xp, x1 = *(const LAS u32x2*)(xp + 16);
                                const u32x4 xa = (u32x4){x0.x, x0.y, x1.x, x1.y};
                                y = mfma32(__builtin_bit_cast(bf16x8, xa), __builtin_bit_cast(bf16x8, pf), y); }
                        }
                        { float ssq = 0.f; const size_t tok = tokb + l;
#pragma unroll
                          for (int q4 = 0; q4 < 4; ++q4) { const int p0 = 32 * pb + 8 * q4 + 4 * hh;
                              const u32x2 zz = *(const u32x2*)(ZG + tok * 1024 + hd * 64 + p0);
                              const float zf[4] = {bflo(zz.x), bfhi(zz.x), bflo(zz.y), bfhi(zz.y)}; float o[4];
#pragma unroll
                              for (int j = 0; j < 4; ++j) { const float xv = bf1(*(const LAS bf16_t*)(L + XL + (p0 + j) * RS + l * 2));
                                  o[j] = (y[4 * q4 + j] + dskip * xv) * silu_f(zf[j]); ssq += o[j] * o[j]; }
                              *(u32x2*)(YCAT + tok * 2048 + hd * 64 + p0) = (u32x2){pk2(o[0], o[1]), pk2(o[2], o[3])}; }
                          ssq += shx(ssq, 32, lane);
                          if (hh == 0) SSQ[tok * 32 + hd * 2 + pb] = ssq; }
                        { const float dec = __expf(cse);
#pragma unroll
                          for (int i = 0; i < 16; ++i) st[i] *= dec;
#pragma unroll
                          for (int ks = 0; ks < 8; ++ks) st = mfma32(*(const LAS bf16x8*)(L + XL + (32 * pb + r) * RS + (16 * ks + 8 * hh) * 2), *(const LAS bf16x8*)(L + WL + (32 * qb + r) * RS + (16 * ks + 8 * hh) * 2), st); }
                    }
                }
#endif
#ifndef NO_ATT
                {
                    constexpr int KL = 0, KRS = 400, VL = 25600, VRS = 144, UW = 147000;
                    unsigned* ctr = (unsigned*)(ws + WS_CTL) + 64 * rep_;
                    for (;;) {
                        __syncthreads();
                        if (tid == 0) *(LAS unsigned*)(L + UW) = atomicAdd(ctr, 1u);
                        __syncthreads();
                        const unsigned u = *(LAS unsigned*)(L + UW);
                        if (u >= 512u) break;
                        const int j = 7 - (int)(u >> 6), bh = (int)(u & 63), b = bh >> 3, h = bh & 7;
                        const int q0 = 256 * j, qw = q0 + 32 * wave, nt = 4 * j + 4, ktmax = 4 * j + (wave >> 1);
                        const size_t tb = (size_t)b * SEQ;
                        bf16x8 qf[12];
#pragma unroll
                        for (int ks = 0; ks < 12; ++ks) qf[ks] = *(const bf16x8*)(Q + (tb + qw + r) * 1536 + h * 192 + 16 * ks + 8 * hh);
                        f32x16 o[4]; o[0] = zero16(); o[1] = zero16(); o[2] = zero16(); o[3] = zero16();
                        float mrun = -1e30f, lrun = 0.f;
                        u32x4 kreg[3], vreg[2];
#define ldtile(kt_) do { const int k0 = 64 * (kt_); \
                            _Pragma("unroll") for (int i = 0; i < 3; ++i) { const int ci = tid + 512 * i, key = ci / 24, cc = ci % 24; \
                                kreg[i] = cc < 16 ? *(const u32x4*)(KN + (tb + k0 + key) * 1024 + h * 128 + cc * 8) : *(const u32x4*)(KPE + (tb + k0 + key) * 64 + (cc - 16) * 8); } \
                            _Pragma("unroll") for (int i = 0; i < 2; ++i) { const int ci = tid + 512 * i, d = ci >> 3, g8 = ci & 7; \
                                vreg[i] = *(const u32x4*)(VT + ((size_t)h * 128 + d) * MT + tb + k0 + g8 * 8); } } while (0)
                        ldtile(0);
                        for (int kt = 0; kt < nt; ++kt) {
                            __syncthreads();
#pragma unroll
                            for (int i = 0; i < 3; ++i) { const int ci = tid + 512 * i, key = ci / 24, cc = ci % 24; *(LAS u32x4*)(L + KL + key * KRS + cc * 16) = kreg[i]; }
#pragma unroll
                            for (int i = 0; i < 2; ++i) { const int ci = tid + 512 * i, d = ci >> 3, g8 = ci & 7; const int pos = 32 * (g8 >> 2) + 16 * ((g8 >> 1) & 1) + 4 * (g8 & 1);
                                *(LAS u32x2*)(L + VL + d * VRS + pos * 2) = (u32x2){vreg[i].x, vreg[i].y};
                                *(LAS u32x2*)(L + VL + d * VRS + (pos + 8) * 2) = (u32x2){vreg[i].z, vreg[i].w}; }
                            __syncthreads();
                            if (kt + 1 < nt) ldtile(kt + 1);
                            if (kt <= ktmax) {
                                f32x16 s0 = zero16(), s1 = zero16();
#pragma unroll
                                for (int ks = 0; ks < 12; ++ks) {
                                    s0 = mfma32(*(const LAS bf16x8*)(L + KL + r * KRS + (16 * ks + 8 * hh) * 2), qf[ks], s0);
                                    s1 = mfma32(*(const LAS bf16x8*)(L + KL + (32 + r) * KRS + (16 * ks + 8 * hh) * 2), qf[ks], s1); }
                                if (kt == ktmax) { const int qp = qw + r, kb0 = 64 * kt;
#pragma unroll
                                    for (int i = 0; i < 16; ++i) { if (kb0 + crow(i, hh) > qp) s0[i] = -1e30f; if (kb0 + 32 + crow(i, hh) > qp) s1[i] = -1e30f; } }
                                float mx = -1e30f;
#pragma unroll
                                for (int i = 0; i < 16; ++i) mx = fmaxf(mx, fmaxf(s0[i], s1[i]));
                                mx = fmaxf(mx, shx(mx, 32, lane));
                                const float mnew = fmaxf(mrun, mx), al = __builtin_amdgcn_exp2f(mrun - mnew);
                                float rsum = 0.f;
#pragma unroll
                                for (int i = 0; i < 16; ++i) { s0[i] = __builtin_amdgcn_exp2f(s0[i] - mnew); s1[i] = __builtin_amdgcn_exp2f(s1[i] - mnew); rsum += s0[i] + s1[i]; }
                                rsum += shx(rsum, 32, lane);
                                lrun = lrun * al + rsum; mrun = mnew;
#pragma unroll
                                for (int db = 0; db < 4; ++db)
#pragma unroll
                                    for (int i = 0; i < 16; ++i) o[db][i] *= al;
#pragma unroll
                                for (int kb = 0; kb < 2; ++kb)
#pragma unroll
                                    for (int s2 = 0; s2 < 2; ++s2) { const f32x16& sv = kb ? s1 : s0;
                                        u32x4 pf; pf.x = pk2(sv[8 * s2], sv[8 * s2 + 1]); pf.y = pk2(sv[8 * s2 + 2], sv[8 * s2 + 3]); pf.z = pk2(sv[8 * s2 + 4], sv[8 * s2 + 5]); pf.w = pk2(sv[8 * s2 + 6], sv[8 * s2 + 7]);
#pragma unroll
                                        for (int db = 0; db < 4; ++db)
                                            o[db] = mfma32(*(const LAS bf16x8*)(L + VL + (32 * db + r) * VRS + (32 * kb + 16 * s2 + 8 * hh) * 2), __builtin_bit_cast(bf16x8, pf), o[db]); }
                            }
                        }
                        const float inv = 1.0f / lrun;
#pragma unroll
                        for (int db = 0; db < 4; ++db)
#pragma unroll
                            for (int q4 = 0; q4 < 4; ++q4) { const int d0 = 32 * db + 8 * q4 + 4 * hh;
                                *(u32x2*)(YCAT + (tb + qw + r) * 2048 + 1024 + h * 128 + d0) = (u32x2){pk2(o[db][4 * q4] * inv, o[db][4 * q4 + 1] * inv), pk2(o[db][4 * q4 + 2] * inv, o[db][4 * q4 + 3] * inv)}; }
                    }
                }
#endif
            PHASE_END
            PHASE_BEGIN
                for (int m0 = gw * 4; m0 < MT; m0 += ngw * 4) {
                    float sq[4]; u32x2 v[4][4];
#pragma unroll
                    for (int r = 0; r < 4; ++r) sq[r] = (lane < 32) ? SSQ[(size_t)(m0 + r) * 32 + lane] : 0.f;
#pragma unroll
                    for (int r = 0; r < 4; ++r)
#pragma unroll
                        for (int j = 0; j < 4; ++j) v[r][j] = *(const u32x2*)(YCAT + (size_t)(m0 + r) * 2048 + 4 * lane + 256 * j);
                    float r0[4], r1[4];
#pragma unroll
                    for (int r = 0; r < 4; ++r) { float s = sq[r];
                        s += shx(s, 1, lane); s += shx(s, 2, lane); s += shx(s, 4, lane); s += shx(s, 8, lane);
                        r0[r] = rsqrtf(rdl(s, 0) * (1.f / 512.f) + LN_EPS); r1[r] = rsqrtf(rdl(s, 16) * (1.f / 512.f) + LN_EPS); }
#pragma unroll
                    for (int j = 0; j < 4; ++j) { const int col = 4 * lane + 256 * j; const f32x4 w = *(const f32x4*)(IN(I_SSDNW) + col);
#pragma unroll
                        for (int r = 0; r < 4; ++r) { const float rr = col < 512 ? r0[r] : r1[r];
                            *(u32x2*)(YCAT + (size_t)(m0 + r) * 2048 + col) = (u32x2){pk2(bflo(v[r][j].x) * rr * w[0], bfhi(v[r][j].x) * rr * w[1]), pk2(bflo(v[r][j].y) * rr * w[2], bfhi(v[r][j].y) * rr * w[3])}; } }
                }
            PHASE_END
            PHASE_BEGIN gemm_resid(YCAT, 2048, (bf16_t*)(ws + WS_WOUT0), ZA, true, lng, lnb, mods_l + 5 * DM, 1.0f, dout); PHASE_END
        } else {
#define UV ((bf16_t*)(ws + WS_UV))
#define VST ((float*)(ws + WS_VST))
#define WSB ((bf16_t*)(ws + WS_WSB))
            PHASE_BEGIN
                pg8::Gemm g{HMOD, (bf16_t*)(ws + WS_WUV1), MT, 4096, DM, DM, DM}; pg8::StaticOrder S; S.init(MT, 4096, G, bid);
                pg8::EpiGeluUV E{UV, IN(I_BUV), VST}; pg8::gemm_phase(L, g, S, E);
            PHASE_END
            PHASE_BEGIN
                constexpr int WLo = 0, VLo = 34816, MRL = 69632, RS = 272;
                const int r = lane & 31, hh = lane >> 5, tbk = wave & 3, dh = wave >> 2;
                for (int u = bid; u < 2048; u += G) {
                    const int g = u & 15, bc = u >> 4; const size_t tok0 = (size_t)bc * 128;
                    __syncthreads();
                    if (tid < 128) { float s = 0.f, q = 0.f; const float* vp = VST + (tok0 + tid) * 64;
#pragma unroll
                        for (int i = 0; i < 16; ++i) { const f32x4 v = *(const f32x4*)(vp + 4 * i); s += v[0] + v[2]; q += v[1] + v[3]; }
                        const float mu = s * (1.f / 2048.f), rs = rsqrtf(fmaxf(q * (1.f / 2048.f) - mu * mu, 0.f) + LN_EPS);
                        *(LAS f32x2*)(L + MRL + tid * 8) = (f32x2){mu, rs}; }
#pragma unroll
                    for (int i = 0; i < 4; ++i) { const int ci = tid + 512 * i, row = ci >> 4, ch = ci & 15;
                        *(LAS u32x4*)(L + WLo + row * RS + ch * 16) = *(const u32x4*)(WSB + ((size_t)g * 128 + row) * 128 + ch * 8); }
                    __syncthreads();
#pragma unroll
                    for (int i = 0; i < 4; ++i) { const int ci = tid + 512 * i, s = ci >> 4, dc = ci & 15, d0 = dc * 8;
                        const u32x4 v = *(const u32x4*)(UV + (tok0 + s) * 4096 + 2048 + g * 128 + d0);
                        const f32x2 mr = *(const LAS f32x2*)(L + MRL + s * 8);
                        const f32x4 g0 = *(const f32x4*)(IN(I_SLNG) + g * 128 + d0), g1 = *(const f32x4*)(IN(I_SLNG) + g * 128 + d0 + 4);
                        const f32x4 b0 = *(const f32x4*)(IN(I_SLNB) + g * 128 + d0), b1 = *(const f32x4*)(IN(I_SLNB) + g * 128 + d0 + 4);
                        const float vv[8] = {bflo(v.x), bfhi(v.x), bflo(v.y), bfhi(v.y), bflo(v.z), bfhi(v.z), bflo(v.w), bfhi(v.w)};
#pragma unroll
                        for (int e = 0; e < 8; ++e) { const float gg = e < 4 ? g0[e & 3] : g1[e & 3], bb = e < 4 ? b0[e & 3] : b1[e & 3];
                            *(LAS bf16_t*)(L + VLo + (d0 + e) * RS + s * 2) = tobf((vv[e] - mr.x) * mr.y * gg + bb); } }
                    __syncthreads();
                    f32x16 acc0 = zero16(), acc1 = zero16();
                    const int t = 32 * tbk + r;
                    for (int ks = 0; ks < 2 * (tbk + 1); ++ks) { const bf16x8 wf = *(const LAS bf16x8*)(L + WLo + t * RS + (16 * ks + 8 * hh) * 2);
                        acc0 = mfma32(*(const LAS bf16x8*)(L + VLo + (64 * dh + r) * RS + (16 * ks + 8 * hh) * 2), wf, acc0);
                        acc1 = mfma32(*(const LAS bf16x8*)(L + VLo + (64 * dh + 32 + r) * RS + (16 * ks + 8 * hh) * 2), wf, acc1); }
                    const float bs = IN(I_BS)[g * 128 + t];
                    bf16_t* up = UV + (tok0 + t) * 4096 + g * 128;
#pragma unroll
                    for (int db = 0; db < 2; ++db)
#pragma unroll
                        for (int q4 = 0; q4 < 4; ++q4) { const int d0 = 64 * dh + 32 * db + 8 * q4 + 4 * hh; const f32x16& ac = db ? acc1 : acc0;
                            const u32x2 uu = *(const u32x2*)(up + d0);
                            *(u32x2*)(up + d0) = (u32x2){pk2(bflo(uu.x) * (ac[4 * q4] + bs), bfhi(uu.x) * (ac[4 * q4 + 1] + bs)), pk2(bflo(uu.y) * (ac[4 * q4 + 2] + bs), bfhi(uu.y) * (ac[4 * q4 + 3] + bs))}; }
                }
            PHASE_END
            PHASE_BEGIN
                pg8::Gemm g{UV, (bf16_t*)(ws + WS_WOUT1), MT, DM, 2048, 4096, 2048}; pg8::StaticOrder S; S.init(MT, DM, G, bid);
                pg8::EpiResid<false> E{bufA, MUR, lng, lnb, mods_l + 5 * DM, bufB, PST}; pg8::gemm_phase(L, g, S, E);
            PHASE_END
        }
        PHASE_BEGIN normmod(bufB, true, lng + DM, lnb + DM, mods_l, 6, 7); PHASE_END
        PHASE_BEGIN gemm_ffin(); PHASE_END
        PHASE_BEGIN gemm_resid(ACT, DFF, FFOUT, bufB, true, lng + DM, lnb + DM, mods_l + 8 * DM, 0.5f, bufA); PHASE_END
    }

__global__ void __launch_bounds__(512, 2) mega_fwd(KArgs a) {
    extern __shared__ __attribute__((aligned(16))) unsigned char lds_raw[];
    LAS unsigned char* L = (LAS unsigned char*)lds_raw;
    cg::grid_group grid = cg::this_grid();
    int ph = 0;
    PHASE_BEGIN
        {
            LAS float* sc = (LAS float*)L;
            LAS float* red = (LAS float*)(L + 32768);
            bool loaded = false;
            for (int it = bid; it < 288; it += G) {
                if (!loaded) { for (int i = tid; i < 8192; i += 512) sc[i] = silu_f(IN(I_C)[i]); loaded = true; }
                __syncthreads();
                const int l = it / 144, j0 = (it % 144) * 64, col = tid & 63, kg = tid >> 6;
                const float* W = IN(l ? I_L1 : I_L0) + j0 + col;
                float acc[8];
#pragma unroll
                for (int b = 0; b < 8; ++b) acc[b] = 0.f;
#pragma unroll 8
                for (int k = kg * 128; k < kg * 128 + 128; ++k) { const float w = W[(size_t)k * 9216];
#pragma unroll
                    for (int b = 0; b < 8; ++b) acc[b] += sc[b * 1024 + k] * w; }
#pragma unroll
                for (int b = 0; b < 8; ++b) red[(kg * 8 + b) * 64 + col] = acc[b];
                __syncthreads();
                { const int b = tid >> 6; float s = IN((l ? I_L1 : I_L0) + 1)[j0 + col];
#pragma unroll
                    for (int k8 = 0; k8 < 8; ++k8) s += red[(k8 * 8 + b) * 64 + col];
                    MODS[(size_t)(l * 8 + b) * 9216 + j0 + col] = s; }
            }
            __syncthreads();
        }
        for (int i = bid * 512 + tid; i < SEQ * 32; i += G * 512) { const int pos = i >> 5, f = i & 31;
            const float inv = 1.0f / powf(10000.0f, (float)(2 * f) / 64.0f); const float ang = (float)pos * inv;
            ROPEC[i] = cosf(ang); ROPES[i] = sinf(ang); }
        CVT(I_L0 + 4, DM, 2 * DFF, WS_FFIN, 2 * DFF, 1);
        CVT(I_L0 + 5, DFF, DM, WS_FFOUT, DM, 0);
        CVT(I_WIN, DM, 3280, WS_WIN, 3328, 0);
        CVT(I_WUQ, 384, 1536, WS_WUQ, 1536, 2);
        CVT(I_WUKV, 256, 2048, WS_WUK, 1024, 3);
        CVT(I_WUKV, 256, 2048, WS_WUV0, 1024, 4);
        CVT(I_WOUT0, 2048, DM, WS_WOUT0, DM, 0);
    PHASE_END

    layer_body<0>(a, L, ph, grid);
    layer_body<1>(a, L, ph, grid);
#undef lng
#undef lnb
    PHASE_BEGIN
        const float* lngF = IN(I_L1 + 2) + 2 * DM; const float* lnbF = IN(I_L1 + 3) + 2 * DM;
        for (int m0 = gw * 4; m0 < MT; m0 += ngw * 4) {
            f32x4 x[4][4]; f32x2 p[4]; float mu[4], rs[4];
#pragma unroll
            for (int r = 0; r < 4; ++r) { p[r] = (f32x2){0.f, 0.f}; if (lane < 16) p[r] = *(const f32x2*)(PST + (size_t)(m0 + r) * 32 + lane * 2); }
#pragma unroll
            for (int r = 0; r < 4; ++r)
#pragma unroll
                for (int j = 0; j < 4; ++j) x[r][j] = *(const f32x4*)(dout + (size_t)(m0 + r) * DM + 4 * lane + 256 * j);
#pragma unroll
            for (int r = 0; r < 4; ++r) { float s = p[r].x, q = p[r].y;
#pragma unroll
                for (int o = 1; o < 16; o <<= 1) { s += shx(s, o, lane); q += shx(q, o, lane); }
                s = rdl(s, 0); q = rdl(q, 0); mu[r] = s * (1.f / DM); rs[r] = rsqrtf(fmaxf(q * (1.f / DM) - mu[r] * mu[r], 0.f) + LN_EPS); }
#pragma unroll
            for (int j = 0; j < 4; ++j) { const int col = 4 * lane + 256 * j; const f32x4 g4 = *(const f32x4*)(lngF + col), b4 = *(const f32x4*)(lnbF + col);
#pragma unroll
                for (int r = 0; r < 4; ++r) *(f32x4*)(dout + (size_t)(m0 + r) * DM + col) = (x[r][j] - mu[r]) * rs[r] * g4 + b4; }
        }
    PHASE_END
}

constexpr int N_PHASES = 64;

extern "C" void kernel_launch(void* const* d_in, const int* in_sizes, int n_in, void* d_out, int out_size, void* d_ws, size_t ws_size, hipStream_t stream) {
    static int grid = 0;
    if (grid == 0) {
        int dev = 0, cus = 0, per_cu = 0;
        hipGetDevice(&dev); hipDeviceGetAttribute(&cus, hipDeviceAttributeMultiprocessorCount, dev);
        hipFuncSetAttribute((const void*)mega_fwd, hipFuncAttributeMaxDynamicSharedMemorySize, LDS_BYTES);
        hipOccupancyMaxActiveBlocksPerMultiprocessor(&per_cu, (const void*)mega_fwd, 512, LDS_BYTES);
        if (per_cu < 1) { fprintf(stderr, "kernel_launch: occupancy query says %d blocks/CU\n", per_cu); per_cu = 1; }
        grid = cus;
        if (n_in != 37 || ws_size < WS_END) fprintf(stderr, "kernel_launch: unexpected n_in %d / ws_size %zu (need %zu)\n", n_in, ws_size, (size_t)WS_END);
    }
    hipMemsetAsync((char*)d_ws + WS_CTL, 0, 4096, stream);
    KArgs a{};
    for (int i = 0; i < 37; ++i) a.in[i] = (const float*)d_in[i];
    a.out = (float*)d_out; a.ws = (unsigned char*)d_ws;
#if MK_MULTI
    for (int p = 0; p < 25; ++p) { a.ph_lo = p; a.ph_hi = p + 1; hipLaunchKernelGGL(mega_fwd, dim3(grid), dim3(512), LDS_BYTES, stream, a); }
#else
    a.ph_lo = 0; a.ph_hi = N_PHASES;
    void* args[] = {&a};
    hipError_t e = hipLaunchCooperativeKernel((const void*)mega_fwd, dim3(grid), dim3(512), args, LDS_BYTES, stream);
    if (e != hipSuccess) fprintf(stderr, "cooperative launch failed: %s (grid %d)\n", hipGetErrorString(e), grid);
#endif
}
```

```cpp
#include <hip/hip_runtime.h>
#include <hip/hip_cooperative_groups.h>
#include <cstdio>
#include <cstdint>
namespace cg = cooperative_groups;

#define DI __device__ __forceinline__
#define LAS __attribute__((address_space(3)))
typedef unsigned short bf16_t;
typedef short bf16x8 __attribute__((ext_vector_type(8)));
typedef float f32x4 __attribute__((ext_vector_type(4)));
typedef float f32x2 __attribute__((ext_vector_type(2)));
typedef float f32x16 __attribute__((ext_vector_type(16)));
typedef unsigned u32x4 __attribute__((ext_vector_type(4)));
typedef unsigned u32x2 __attribute__((ext_vector_type(2)));

#ifndef MK_MULTI
#define MK_MULTI 0
#endif

constexpr int DM = 1024, NB = 8, SEQ = 2048, MT = NB * SEQ, DFF = 2816;
constexpr float LN_EPS = 1e-5f;
constexpr float DN_ALPHA = 1.41421356237f;
constexpr float QSCALE = 0.07216878364870322f * 1.4426950408889634f;

constexpr size_t MiB = 1u << 20;
constexpr size_t WS_CTL = 0, WS_MUR = MiB / 8, WS_MODS = MiB / 4, WS_ROPEC = 1 * MiB, WS_ROPES = MiB + MiB / 4, WS_PST = 2 * MiB;
constexpr size_t WS_FFIN = 4 * MiB, WS_FFOUT = 15 * MiB;
constexpr size_t WS_WIN = 21 * MiB, WS_WUQ = 27 * MiB + MiB / 2, WS_WUK = 28 * MiB + 3 * MiB / 4, WS_WUV0 = 29 * MiB + MiB / 4, WS_WOUT0 = 30 * MiB;
constexpr size_t WS_WUV1 = 21 * MiB, WS_WOUT1 = 29 * MiB, WS_WSB = 33 * MiB;
constexpr size_t WS_ZA = 34 * MiB, WS_HMOD = 98 * MiB, WS_R = 130 * MiB;
constexpr size_t WS_ACT = WS_R;
constexpr size_t WS_ZG = WS_R, WS_XT = WS_R + 32 * MiB, WS_BT = WS_R + 64 * MiB, WS_BN = WS_R + 72 * MiB, WS_CN = WS_R + 80 * MiB, WS_DT = WS_R + 88 * MiB, WS_CS = WS_R + 89 * MiB,
                 WS_CKVN = WS_R + 90 * MiB, WS_PROJ2 = WS_R + 98 * MiB, WS_YCAT = WS_R + 90 * MiB, WS_KN = WS_R + 154 * MiB;
constexpr size_t WS_VT = WS_HMOD;
constexpr size_t WS_UV = WS_R, WS_VST = WS_R + 128 * MiB;
constexpr size_t WS_END = 316 * MiB;
constexpr size_t DO_Q = 0, DO_CQN = 48 * MiB, DO_KPE = 60 * MiB, DO_SSQ = 62 * MiB;
constexpr int LDS_BYTES = 147456;

DI unsigned pk2(float lo, float hi) { typedef __bf16 b2 __attribute__((ext_vector_type(2))); f32x2 v = {lo, hi}; b2 b = __builtin_convertvector(v, b2); return __builtin_bit_cast(unsigned, b); }
DI float bflo(unsigned u) { return __uint_as_float(u << 16); }
DI float bfhi(unsigned u) { return __uint_as_float(u & 0xffff0000u); }
DI float bf1(bf16_t b) { return __uint_as_float(((unsigned)b) << 16); }
DI bf16_t tobf(float f) { return (bf16_t)(pk2(f, 0.f) & 0xffffu); }
DI float silu_f(float a) { return a * __builtin_amdgcn_rcpf(1.f + __expf(-a)); }
DI float shx(float v, int o, int lane) { return __builtin_bit_cast(float, __builtin_amdgcn_ds_bpermute((lane ^ o) << 2, __builtin_bit_cast(int, v))); }
DI float rdl(float v, int l) { return __builtin_bit_cast(float, __builtin_amdgcn_readlane(__builtin_bit_cast(int, v), l)); }
DI float wave_sum(float v, int lane) {
#pragma unroll
    for (int o = 1; o < 64; o <<= 1) v += shx(v, o, lane);
    return v;
}
DI f32x16 mfma32(bf16x8 a, bf16x8 b, f32x16 c) { return __builtin_amdgcn_mfma_f32_32x32x16_bf16(a, b, c, 0, 0, 0); }
DI int crow(int i, int hh) { return (i & 3) + 8 * (i >> 2) + 4 * hh; }
DI f32x16 zero16() { f32x16 z; for (int i = 0; i < 16; ++i) z[i] = 0.f; return z; }

namespace pg8 {
constexpr int BM = 256, BK = 64, HALF = 128, HTB = HALF * BK * 2, STAGE_BYTES = 8 * HTB, NXCD = 8, WGM = 8;
__host__ __device__ __forceinline__ int lds_byte(int r, int c) { const int st = (r >> 4) * 2 + (c >> 5), rr = r & 15, cc = c & 31, ob = rr * 64 + cc * 2; return st * 1024 + (ob ^ (((ob >> 9) & 1) << 5)); }
__host__ __device__ __forceinline__ void stage_rc(int b, int& R, int& C) { const int st = b / 1024, sb = b % 1024, swz = sb ^ (((sb >> 9) & 1) << 5); R = (st >> 1) * 16 + swz / 64; C = (st & 1) * 32 + (swz % 64) / 2; }
__host__ __device__ __forceinline__ int perm32(int rho) { const int n = rho >> 4, i = rho & 15; return 8 * (i >> 2) + 4 * n + (i & 3); }
struct Unit { int pm, pn; };
struct Gemm { const bf16_t* A; const bf16_t* Bt; int M, N, K, lda, ldb; };
struct StaticOrder {
    int nM, nN, nwg, G, c;
    __host__ __device__ void init(int M, int N, int G_, int c_) { nM = M / BM; nN = N / BM; nwg = nM * nN; G = G_; c = c_; }
    __host__ __device__ bool next(int i, Unit& u) const {
        const long L = (long)i * G + c; if (L >= nwg) return false;
        int wgid = (int)L; { const int q = nwg / NXCD, r = nwg % NXCD, xcd = wgid % NXCD, off = wgid / NXCD; wgid = (xcd < r ? xcd * (q + 1) : r * (q + 1) + (xcd - r) * q) + off; }
        const int nig = WGM * nN, gid = wgid / nig, fm = gid * WGM, gsz = (nM - fm) < WGM ? (nM - fm) : WGM;
        u.pm = fm + ((wgid % nig) % gsz); u.pn = (wgid % nig) / gsz; return true;
    }
};
template <class Epi>
__device__ __forceinline__ void gemm_phase(LAS unsigned char* lds, const Gemm g, const StaticOrder& S, const Epi& E) {
    int tid = threadIdx.x; asm volatile("" : "+v"(tid));
    const int wid = __builtin_amdgcn_readfirstlane(tid >> 6), lane = tid & 63, wr = wid >> 2, wc = wid & 3, fr = lane & 15, fq = lane >> 4;
    const int K = g.K, nt = K / BK;
    unsigned voffA[2], voffB[2];
#pragma unroll
    for (int i = 0; i < 2; ++i) { int R, C; stage_rc(tid * 16 + i * 8192, R, C); const int Rb = Epi::PERM ? ((R & ~31) + perm32(R & 31)) : R;
        voffA[i] = (unsigned)(R * g.lda + C) * 2u; voffB[i] = (unsigned)(Rb * g.ldb + C) * 2u; }
    const size_t kstep = (size_t)(BK * 2);
    const size_t hstepA = (size_t)HALF * g.lda * 2, hstepB = (size_t)HALF * g.ldb * 2;
    const size_t tstepA = 2 * hstepA, tstepB = 2 * hstepB;
    const unsigned ldsw = (unsigned)wid * 1024u;
    const int aoff = lds_byte(wr * 64 + fr, fq * 8), boff = lds_byte(wc * 32 + fr, fq * 8);
#define PG8_SA(b, h) (((b) * 2 + (h)) * HTB)
#define PG8_SB(b, h) ((4 + (b) * 2 + (h)) * HTB)
#define PG8_STAGE(bufoff, gbase, voff) do { _Pragma("unroll") for (int _i = 0; _i < 2; ++_i) \
        __builtin_amdgcn_global_load_lds((const unsigned*)((const char*)(gbase) + (voff)[_i]), (LAS unsigned*)(lds + (bufoff) + ldsw + _i * 8192), 16, 0, 0); } while (0)
#define PG8_LDA(dst, b, h) do { _Pragma("unroll") for (int m = 0; m < 4; ++m) _Pragma("unroll") for (int k = 0; k < 2; ++k) dst[m][k] = *(const LAS bf16x8*)(lds + PG8_SA(b, h) + aoff + m * 2048 + k * 1024); } while (0)
#define PG8_LDB(dst, b, h) do { _Pragma("unroll") for (int n = 0; n < 2; ++n) _Pragma("unroll") for (int k = 0; k < 2; ++k) dst[n][k] = *(const LAS bf16x8*)(lds + PG8_SB(b, h) + boff + n * 2048 + k * 1024); } while (0)
#define PG8_MMA(ai, bj, At, Bt) do { __builtin_amdgcn_s_setprio(1); _Pragma("unroll") for (int m = 0; m < 4; ++m) _Pragma("unroll") for (int n = 0; n < 2; ++n) _Pragma("unroll") for (int k = 0; k < 2; ++k) \
        acc[ai][bj][m][n] = __builtin_amdgcn_mfma_f32_16x16x32_bf16(Bt[n][k], At[m][k], acc[ai][bj][m][n], 0, 0, 0); __builtin_amdgcn_s_setprio(0); } while (0)
#define PG8_WAIT_V(n) asm volatile("s_waitcnt vmcnt(" #n ")" ::: "memory")
#define PG8_WAIT_L(n) asm volatile("s_waitcnt lgkmcnt(" #n ")" ::: "memory")
#define PG8_BAR __builtin_amdgcn_s_barrier()
#define PG8_SCHED __builtin_amdgcn_sched_barrier(0)
    Unit cur, nxt; int ui = 0;
    if (!S.next(0, cur)) return;
    f32x4 acc[2][2][4][2];
#pragma unroll
    for (int a = 0; a < 2; ++a)
#pragma unroll
        for (int b = 0; b < 2; ++b)
#pragma unroll
            for (int m = 0; m < 4; ++m)
#pragma unroll
                for (int n = 0; n < 2; ++n) acc[a][b][m][n] = (f32x4){0.f, 0.f, 0.f, 0.f};
    bf16x8 At[4][2], B0[2][2], B1[2][2];
    const char* cA = (const char*)g.A + (size_t)cur.pm * tstepA; const char* cB = (const char*)g.Bt + (size_t)cur.pn * tstepB;
    PG8_STAGE(PG8_SB(0, 0), cB, voffB); PG8_STAGE(PG8_SB(0, 1), cB + hstepB, voffB); PG8_STAGE(PG8_SA(0, 0), cA, voffA); PG8_STAGE(PG8_SA(0, 1), cA + hstepA, voffA);
    if (wr == 1) PG8_BAR;
    PG8_WAIT_V(2); PG8_BAR;
    PG8_STAGE(PG8_SB(1, 0), cB + kstep, voffB); PG8_STAGE(PG8_SA(1, 0), cA + kstep, voffA); PG8_STAGE(PG8_SB(1, 1), cB + hstepB + kstep, voffB);
    PG8_WAIT_V(6); PG8_BAR;
    for (;;) {
        const bool has_next = S.next(ui + 1, nxt);
        const char* nA = has_next ? (const char*)g.A + (size_t)nxt.pm * tstepA : cA; const char* nB = has_next ? (const char*)g.Bt + (size_t)nxt.pn * tstepB : cB;
#pragma unroll 1
        for (int t = 0; t < nt; t += 2) {
            const bool last = (t == nt - 2);
            const char* a1 = cA + (size_t)(t + 1) * kstep;
            const char* a2 = last ? nA : cA + (size_t)(t + 2) * kstep; const char* b2 = last ? nB : cB + (size_t)(t + 2) * kstep;
            const char* a3 = a2 + kstep; const char* b3 = b2 + kstep;
            PG8_LDB(B0, 0, 0); PG8_LDB(B1, 0, 1); PG8_SCHED; PG8_LDA(At, 0, 0); PG8_STAGE(PG8_SA(1, 1), a1 + hstepA, voffA);
            PG8_WAIT_V(8); PG8_WAIT_L(0); PG8_BAR; PG8_MMA(0, 0, At, B0); PG8_MMA(0, 1, At, B1); PG8_BAR; PG8_SCHED;
            PG8_LDA(At, 0, 1); PG8_STAGE(PG8_SB(0, 0), b2, voffB); PG8_STAGE(PG8_SB(0, 1), b2 + hstepB, voffB); PG8_STAGE(PG8_SA(0, 0), a2, voffA);
            PG8_WAIT_V(8); PG8_WAIT_L(0); PG8_BAR; PG8_MMA(1, 0, At, B0); PG8_MMA(1, 1, At, B1); PG8_BAR; PG8_SCHED;
            PG8_LDB(B0, 1, 0); PG8_LDB(B1, 1, 1); PG8_SCHED; PG8_LDA(At, 1, 0); PG8_STAGE(PG8_SA(0, 1), a2 + hstepA, voffA);
            PG8_WAIT_V(8); PG8_WAIT_L(0); PG8_BAR; PG8_MMA(0, 0, At, B0); PG8_MMA(0, 1, At, B1); PG8_BAR; PG8_SCHED;
            PG8_LDA(At, 1, 1); PG8_STAGE(PG8_SB(1, 0), b3, voffB); PG8_STAGE(PG8_SB(1, 1), b3 + hstepB, voffB); PG8_STAGE(PG8_SA(1, 0), a3, voffA);
            PG8_WAIT_V(8); PG8_WAIT_L(0); PG8_BAR; PG8_MMA(1, 0, At, B0); PG8_MMA(1, 1, At, B1); PG8_BAR; PG8_SCHED;
        }
        if (wr == 0) PG8_BAR;
        { int fr2 = fr, fq2 = fq; asm volatile("" : "+v"(fr2), "+v"(fq2)); E(acc, cur, wr, wc, fr2, fq2); }
        if (!has_next) break;
#pragma unroll
        for (int a = 0; a < 2; ++a)
#pragma unroll
            for (int b = 0; b < 2; ++b)
#pragma unroll
                for (int m = 0; m < 4; ++m)
#pragma unroll
                    for (int n = 0; n < 2; ++n) acc[a][b][m][n] = (f32x4){0.f, 0.f, 0.f, 0.f};
        cur = nxt; cA = nA; cB = nB; ++ui;
        if (wr == 1) PG8_BAR;
    }
    PG8_WAIT_V(0);
    PG8_BAR;
#undef PG8_SA
#undef PG8_SB
#undef PG8_STAGE
#undef PG8_LDA
#undef PG8_LDB
#undef PG8_MMA
#undef PG8_WAIT_V
#undef PG8_WAIT_L
#undef PG8_BAR
#undef PG8_SCHED
}

DI f32x2 gelu_pk(f32x2 v) {
    const f32x2 av = __builtin_elementwise_abs(v), d = av * 0.2316418882f + 1.0f;
    f32x2 t; t.x = __builtin_amdgcn_rcpf(d.x); t.y = __builtin_amdgcn_rcpf(d.y);
    f32x2 q = t * 0.5307027145f + (-0.7265760135f); q = q * t + 0.7107068705f; q = q * t + (-0.142248368f); q = q * t + 0.127414796f; q = q * t;
    const f32x2 s = (v * v) * (-0.72134752044f);
    f32x2 e; e.x = __builtin_amdgcn_exp2f(s.x); e.y = __builtin_amdgcn_exp2f(s.y);
    const f32x2 m = v * (q * e), r = v - m;
    f32x2 o; o.x = v.x < 0.f ? m.x : r.x; o.y = v.y < 0.f ? m.y : r.y; return o;
}
struct EpiBf16 {
    static constexpr bool PERM = true;
    bf16_t* O1; int ld1; bf16_t* O2; int ld2; int split_pn;
    DI void operator()(const f32x4 (&acc)[2][2][4][2], const Unit& u, int wr, int wc, int fr, int fq) const {
        const int row0 = u.pm * BM + wr * 64 + fr;
        bf16_t* base; int ld, colt;
        if (u.pn < split_pn) { base = O1; ld = ld1; colt = u.pn * BM; } else { base = O2; ld = ld2; colt = (u.pn - split_pn) * BM; }
        const int col0 = colt + wc * 32 + 8 * fq;
#pragma unroll
        for (int ai = 0; ai < 2; ++ai)
#pragma unroll
            for (int m = 0; m < 4; ++m) { bf16_t* rowp = base + (size_t)(row0 + ai * HALF + m * 16) * ld + col0;
#pragma unroll
                for (int bj = 0; bj < 2; ++bj) { const f32x4 v0 = acc[ai][bj][m][0], v1 = acc[ai][bj][m][1];
                    u32x4 w; w.x = pk2(v0[0], v0[1]); w.y = pk2(v0[2], v0[3]); w.z = pk2(v1[0], v1[1]); w.w = pk2(v1[2], v1[3]);
                    *(u32x4*)(rowp + bj * HALF) = w; } }
    }
};
struct EpiSwiGLU {
    static constexpr bool PERM = true;
    bf16_t* O; int ldc;
    DI void operator()(const f32x4 (&acc)[2][2][4][2], const Unit& u, int wr, int wc, int fr, int fq) const {
        const int row0 = u.pm * BM + wr * 64 + fr, col0 = u.pn * HALF + wc * 32 + 8 * fq;
#pragma unroll
        for (int ai = 0; ai < 2; ++ai)
#pragma unroll
            for (int m = 0; m < 4; ++m) { bf16_t* rowp = O + (size_t)(row0 + ai * HALF + m * 16) * ldc + col0;
                float o[8];
#pragma unroll
                for (int n = 0; n < 2; ++n)
#pragma unroll
                    for (int j = 0; j < 4; ++j) o[n * 4 + j] = silu_f(acc[ai][0][m][n][j]) * acc[ai][1][m][n][j];
                u32x4 w; w.x = pk2(o[0], o[1]); w.y = pk2(o[2], o[3]); w.z = pk2(o[4], o[5]); w.w = pk2(o[6], o[7]);
                *(u32x4*)rowp = w; }
    }
};
template <bool HALFS> struct EpiResid {
    static constexpr bool PERM = false; static constexpr float scale = HALFS ? 0.5f : 1.0f;
    const float* zprev; const float* mur; const float* lng; const float* lnb;
    const float* gate;
    float* zout; float* pst;
    DI void operator()(const f32x4 (&acc)[2][2][4][2], const Unit& u, int wr, int wc, int fr, int fq) const {
        const int row0 = u.pm * BM + wr * 64 + fr, col0 = u.pn * BM + wc * 32 + 4 * fq, lane = fr | (fq << 4);
        const float* gt = gate + (size_t)((u.pm * BM) / SEQ) * 9216;
#pragma unroll
        for (int ai = 0; ai < 2; ++ai)
#pragma unroll
            for (int m = 0; m < 4; ++m) { const int row = row0 + ai * HALF + m * 16; const size_t off = (size_t)row * DM + col0;
                float mu = 0.f, rs = 1.f; if (mur) { const f32x2 mr = *(const f32x2*)(mur + 2 * row); mu = mr.x; rs = mr.y; }
                float s = 0.f, q = 0.f;
#pragma unroll
                for (int bj = 0; bj < 2; ++bj)
#pragma unroll
                    for (int n = 0; n < 2; ++n) { const int co = bj * HALF + n * 16;
                        f32x4 xr = *(const f32x4*)(zprev + off + co);
                        if (mur) { const f32x4 g4 = *(const f32x4*)(lng + col0 + co), b4 = *(const f32x4*)(lnb + col0 + co); xr = (xr - mu) * rs * g4 + b4; }
                        const f32x4 g1 = *(const f32x4*)(gt + col0 + co);
                        const f32x4 z = xr * DN_ALPHA + (g1 + 1.0f) * (acc[ai][bj][m][n] * scale);
                        *(f32x4*)(zout + off + co) = z;
                        s += (z[0] + z[1]) + (z[2] + z[3]); q += (z[0] * z[0] + z[1] * z[1]) + (z[2] * z[2] + z[3] * z[3]); }
                s += shx(s, 16, lane); s += shx(s, 32, lane); q += shx(q, 16, lane); q += shx(q, 32, lane);
                if (fq == 0) *(f32x2*)(pst + (size_t)row * 32 + (u.pn * 4 + wc) * 2) = (f32x2){s, q};
                asm volatile("" ::: "memory"); }
    }
};
struct EpiQRope {
    static constexpr bool PERM = true;
    bf16_t* Q; const float* rc; const float* rs;
    DI void operator()(const f32x4 (&acc)[2][2][4][2], const Unit& u, int wr, int wc, int fr, int fq) const {
        const int row0 = u.pm * BM + wr * 64 + fr;
        if (u.pn < 4) {
#pragma unroll
            for (int ai = 0; ai < 2; ++ai)
#pragma unroll
                for (int m = 0; m < 4; ++m) { bf16_t* rowp = Q + (size_t)(row0 + ai * HALF + m * 16) * 1536 + wc * 32 + 8 * fq;
#pragma unroll
                    for (int bj = 0; bj < 2; ++bj) { const f32x4 v0 = acc[ai][bj][m][0] * QSCALE, v1 = acc[ai][bj][m][1] * QSCALE;
                        u32x4 w; w.x = pk2(v0[0], v0[1]); w.y = pk2(v0[2], v0[3]); w.z = pk2(v1[0], v1[1]); w.w = pk2(v1[2], v1[3]);
                        *(u32x4*)(rowp + (2 * u.pn + bj) * 192) = w; } }
        } else {
            const int head = 4 * (u.pn - 4) + wc;
#pragma unroll
            for (int ai = 0; ai < 2; ++ai)
#pragma unroll
                for (int m = 0; m < 4; ++m) { const int row = row0 + ai * HALF + m * 16; const int pos = row & (SEQ - 1);
                    bf16_t* rowp = Q + (size_t)row * 1536 + head * 192 + 128 + 8 * fq;
#pragma unroll
                    for (int n = 0; n < 2; ++n) { const f32x4 c4 = *(const f32x4*)(rc + pos * 32 + 8 * fq + 4 * n), s4 = *(const f32x4*)(rs + pos * 32 + 8 * fq + 4 * n);
                        const f32x4 x1 = acc[ai][0][m][n], x2 = acc[ai][1][m][n];
                        const f32x4 a = (x1 * c4 - x2 * s4) * QSCALE, b = (x2 * c4 + x1 * s4) * QSCALE;
                        *(u32x2*)(rowp + 4 * n) = (u32x2){pk2(a[0], a[1]), pk2(a[2], a[3])};
                        *(u32x2*)(rowp + 32 + 4 * n) = (u32x2){pk2(b[0], b[1]), pk2(b[2], b[3])}; }
                    asm volatile("" ::: "memory"); }
        }
    }
};
struct EpiGeluUV {
    static constexpr bool PERM = true;
    bf16_t* O; const float* bias; float* vst;
    DI void operator()(const f32x4 (&acc)[2][2][4][2], const Unit& u, int wr, int wc, int fr, int fq) const {
        const int row0 = u.pm * BM + wr * 64 + fr, col0 = u.pn * BM + wc * 32 + 8 * fq, lane = fr | (fq << 4);
#pragma unroll
        for (int ai = 0; ai < 2; ++ai)
#pragma unroll
            for (int m = 0; m < 4; ++m) { const int row = row0 + ai * HALF + m * 16; bf16_t* rowp = O + (size_t)row * 4096 + col0;
                float s = 0.f, q = 0.f;
#pragma unroll
                for (int bj = 0; bj < 2; ++bj) {
                    const f32x4 b0 = *(const f32x4*)(bias + col0 + bj * HALF), b1 = *(const f32x4*)(bias + col0 + bj * HALF + 4);
                    const f32x4 v0 = acc[ai][bj][m][0] + b0, v1 = acc[ai][bj][m][1] + b1;
                    const f32x2 a = gelu_pk((f32x2){v0[0], v0[1]}), b = gelu_pk((f32x2){v0[2], v0[3]}), c = gelu_pk((f32x2){v1[0], v1[1]}), d = gelu_pk((f32x2){v1[2], v1[3]});
                    u32x4 w; w.x = pk2(a.x, a.y); w.y = pk2(b.x, b.y); w.z = pk2(c.x, c.y); w.w = pk2(d.x, d.y);
                    *(u32x4*)(rowp + bj * HALF) = w;
                    s += (a.x + a.y) + (b.x + b.y) + (c.x + c.y) + (d.x + d.y);
                    q += (a.x * a.x + a.y * a.y) + (b.x * b.x + b.y * b.y) + (c.x * c.x + c.y * c.y) + (d.x * d.x + d.y * d.y); }
                if (u.pn >= 8) { s += shx(s, 16, lane); s += shx(s, 32, lane); q += shx(q, 16, lane); q += shx(q, 32, lane);
                    if (fq == 0) *(f32x2*)(vst + (size_t)row * 64 + ((u.pn - 8) * 4 + wc) * 2) = (f32x2){s, q}; }
                asm volatile("" ::: "memory"); }
    }
};
}

DI int cvt_src(int mode, int nb) {
    if (mode == 1) { return ((nb >> 2) & 1) * DFF + 128 * (nb >> 3) + 32 * (nb & 3); }
    if (mode == 2) { const int t = nb >> 3, half = (nb >> 2) & 1, q = nb & 3;
        return t < 4 ? (2 * t + half) * 192 + 32 * q : (4 * (t - 4) + q) * 192 + 128 + 32 * half; }
    if (mode == 3) { return (nb >> 2) * 256 + 32 * (nb & 3); }
    if (mode == 4) { return (nb >> 2) * 256 + 128 + 32 * (nb & 3); }
    return 32 * nb;
}
DI void cvt_job(const float* W, int K, int N, bf16_t* Wt, int Nout, int mode, LAS float* scr, int gw, int ngw, int lane) {
    const int nblk = Nout / 32, nitems = (K / 64) * nblk;
    for (int it = gw; it < nitems; it += ngw) {
        const int kb = it / nblk, nb = it % nblk, k0 = 64 * kb, n0 = 32 * nb;
        const int sc = cvt_src(mode, nb) + (lane & 31); const bool ok = sc < N;
#pragma unroll 8
        for (int i = 0; i < 32; ++i) { const int kk = 2 * i + (lane >> 5); scr[kk * 33 + (lane & 31)] = ok ? W[(size_t)(k0 + kk) * N + sc] : 0.f; }
        asm volatile("s_waitcnt lgkmcnt(0)" ::: "memory");
        const int c = lane & 7;
#pragma unroll
        for (int j = 0; j < 4; ++j) { const int n = (lane >> 3) + 8 * j; const LAS float* s = scr + (8 * c) * 33 + n;
            u32x4 o; o.x = pk2(s[0 * 33], s[1 * 33]); o.y = pk2(s[2 * 33], s[3 * 33]); o.z = pk2(s[4 * 33], s[5 * 33]); o.w = pk2(s[6 * 33], s[7 * 33]);
            *(u32x4*)(Wt + (size_t)(n0 + n) * K + k0 + 8 * c) = o; }
        asm volatile("s_waitcnt lgkmcnt(0)" ::: "memory");
    }
}

#define XB_TMO      128
#define XB_XCNT(j)  (256  + 64 * (j))
#define XB_XSUB(j)  (1280 + 64 * (j))
#define XB_XGEN(j)  (2304 + 64 * (j))
#define XB_TOP      3328
#define XB_TOPGEN   3392
#define XCD_BAR_WORDS 3456
#define XB_SPIN_CAP (1u << 18)

__device__ __forceinline__ unsigned xb_ld(unsigned* p)              { return __hip_atomic_load(p, __ATOMIC_RELAXED, __HIP_MEMORY_SCOPE_AGENT); }
__device__ __forceinline__ unsigned xb_add(unsigned* p, unsigned v) { return __hip_atomic_fetch_add(p, v, __ATOMIC_RELAXED, __HIP_MEMORY_SCOPE_AGENT); }
__device__ __forceinline__ unsigned xb_xcc_id() { return (unsigned)__builtin_amdgcn_s_getreg((3 << 11) | 20) & 0xFu; }
#define XB_SPIN(cond, bar) do { unsigned _sp = 0; while (cond) { __builtin_amdgcn_s_sleep(1); \
    if ((++_sp & 255u) == 0u) { if (xb_ld(&(bar)[XB_TMO])) break; if (_sp > XB_SPIN_CAP) { atomicAdd(&(bar)[XB_TMO], 1u); break; } } } } while (0)

struct XcdBarrier {
    unsigned* bar; unsigned x;
    volatile LAS unsigned* st;
};

__device__ __forceinline__ XcdBarrier xcd_barrier_post(unsigned* bar, volatile LAS unsigned* st) {
    XcdBarrier b; b.bar = bar; b.x = xb_xcc_id(); b.st = st;
    if (threadIdx.x == 0) (void)xb_add(&bar[XB_XCNT(b.x)], 1u);
    return b;
}
__device__ __forceinline__ void xcd_barrier_complete(unsigned* bar, unsigned x, unsigned& nloc, unsigned& nx) {
    const unsigned G = gridDim.x * gridDim.y * gridDim.z;
    unsigned sum, cnt, mine, sp = 0u;
    for (;;) {
        sum = 0u; cnt = 0u; mine = 0u;
#pragma unroll
        for (unsigned j = 0; j < 16; ++j) { const unsigned c = xb_ld(&bar[XB_XCNT(j)]); sum += c; cnt += (c > 0u) ? 1u : 0u; mine = (j == x) ? c : mine; }
        if (sum == G) break;
        __builtin_amdgcn_s_sleep(1);
        if ((++sp & 255u) == 0u) { if (xb_ld(&bar[XB_TMO])) break; if (sp > XB_SPIN_CAP) { atomicAdd(&bar[XB_TMO], 1u); break; } }
    }
    nloc = mine > 0u ? mine : 1u; nx = cnt > 0u ? cnt : 1u;
}

__device__ __forceinline__ void xcd_barrier(const XcdBarrier& b) {
    asm volatile("s_waitcnt vmcnt(0)" ::: "memory");
    __syncthreads();
    if (threadIdx.x == 0) {
        unsigned* bar = b.bar;
        __builtin_amdgcn_s_waitcnt(0);
        unsigned nloc = b.st[0], nx = b.st[1];
        if (nloc == 0u) { xcd_barrier_complete(bar, b.x, nloc, nx); b.st[0] = nloc; b.st[1] = nx; }
        const unsigned old = xb_add(&bar[XB_XSUB(b.x)], 1u);
        const unsigned gen = old / nloc;
        if (old + 1u == (gen + 1u) * nloc) {
            __builtin_amdgcn_fence(__ATOMIC_RELEASE, "agent");
            asm volatile("s_waitcnt vmcnt(0)" ::: "memory");
            const unsigned og = xb_add(&bar[XB_TOP], 1u);
            const unsigned tg = og / nx;
            if (og + 1u == (tg + 1u) * nx) xb_add(&bar[XB_TOPGEN], 1u);
            else XB_SPIN(xb_ld(&bar[XB_TOPGEN]) == tg, bar);
            __builtin_amdgcn_fence(__ATOMIC_ACQUIRE, "agent");
            xb_add(&bar[XB_XGEN(b.x)], 1u);
            asm volatile("s_waitcnt vmcnt(0)" ::: "memory");
        } else {
            XB_SPIN(xb_ld(&bar[XB_XGEN(b.x)]) == gen, bar);
            __builtin_amdgcn_fence(__ATOMIC_ACQUIRE, "agent");
            asm volatile("s_waitcnt vmcnt(0)" ::: "memory");
        }
    }
    __syncthreads();
}
constexpr int LDS_BST = 147264;
constexpr int CTL_BAR_WORD = 1024;

DI void normmod_f(const float* zin, bool has_ln, const float* lng, const float* lnb, const float* mods_l, int ksh, int ksc, const float* PST, float* MUR, bf16_t* HMOD, int gw, int ngw, int lane) {
    for (int m0 = gw * 4; m0 < MT; m0 += ngw * 4) {
        f32x4 x[4][4]; float mu[4], rs[4]; f32x2 p[4];
#pragma unroll
        for (int r = 0; r < 4; ++r) { p[r] = (f32x2){0.f, 0.f}; if (has_ln && lane < 16) p[r] = *(const f32x2*)(PST + (size_t)(m0 + r) * 32 + lane * 2); }
#pragma unroll
        for (int r = 0; r < 4; ++r)
#pragma unroll
            for (int j = 0; j < 4; ++j) x[r][j] = *(const f32x4*)(zin + (size_t)(m0 + r) * DM + 4 * lane + 256 * j);
#pragma unroll
        for (int r = 0; r < 4; ++r) { mu[r] = 0.f; rs[r] = 1.f;
            if (has_ln) { float s = p[r].x, q = p[r].y;
#pragma unroll
                for (int o = 1; o < 16; o <<= 1) { s += shx(s, o, lane); q += shx(q, o, lane); }
                s = rdl(s, 0); q = rdl(q, 0); mu[r] = s * (1.f / DM); rs[r] = rsqrtf(fmaxf(q * (1.f / DM) - mu[r] * mu[r], 0.f) + LN_EPS);
                if (lane == 0) *(f32x2*)(MUR + 2 * (m0 + r)) = (f32x2){mu[r], rs[r]}; } }
        const float* mb = mods_l + (size_t)(m0 / SEQ) * 9216;
#pragma unroll
        for (int j = 0; j < 4; ++j) { const int col = 4 * lane + 256 * j;
            const f32x4 sc1 = *(const f32x4*)(mb + ksc * DM + col) + 1.0f, sh = *(const f32x4*)(mb + ksh * DM + col);
            f32x4 g4 = (f32x4){1.f, 1.f, 1.f, 1.f}, b4 = (f32x4){0.f, 0.f, 0.f, 0.f};
            if (has_ln) { g4 = *(const f32x4*)(lng + col); b4 = *(const f32x4*)(lnb + col); }
#pragma unroll
            for (int r = 0; r < 4; ++r) { f32x4 xx = x[r][j]; if (has_ln) xx = (xx - mu[r]) * rs[r] * g4 + b4;
                const f32x4 h = xx * sc1 + sh;
                *(u32x2*)(HMOD + (size_t)(m0 + r) * DM + col) = (u32x2){pk2(h[0], h[1]), pk2(h[2], h[3])}; } }
    }
}

typedef const float* __attribute__((address_space(4))) KPTR_unused;
typedef const float* KPTR_t; typedef __attribute__((address_space(4))) KPTR_t KPTR;
#define IN(i) (kin[i])
struct KArgs { const float* in[37]; float* out; unsigned char* ws; int ph_lo, ph_hi; };

enum { I_X = 0, I_C = 1, I_L0 = 2, I_WIN = 10, I_CONVW = 11, I_CONVB = 12, I_DTB = 13, I_ALOG = 14, I_DSKIP = 15, I_SSDNW = 16, I_QNW = 17, I_WUQ = 18, I_KVNW = 19, I_WUKV = 20, I_WOUT0 = 21,
       I_L1 = 22, I_WUV = 30, I_BUV = 31, I_SLNG = 32, I_SLNB = 33, I_WS = 34, I_BS = 35, I_WOUT1 = 36 };

#define MODS ((float*)(ws + WS_MODS))
#define ROPEC ((float*)(ws + WS_ROPEC))
#define ROPES ((float*)(ws + WS_ROPES))
#define PST ((float*)(ws + WS_PST))
#define MUR ((float*)(ws + WS_MUR))
#define HMOD ((bf16_t*)(ws + WS_HMOD))
#define ZA ((float*)(ws + WS_ZA))
#define ACT ((bf16_t*)(ws + WS_ACT))
#define FFIN ((bf16_t*)(ws + WS_FFIN))
#define FFOUT ((bf16_t*)(ws + WS_FFOUT))
#ifndef PROBE_DUP
#define PROBE_DUP 0u
#endif
#define PHASE_BEGIN if (ph >= a.ph_lo && ph < a.ph_hi) for (int rep_ = 0; rep_ <= (int)((PROBE_DUP >> ph) & 1u); ++rep_) { int tid = threadIdx.x; asm volatile("" : "+v"(tid)); int bid = blockIdx.x; asm volatile("" : "+s"(bid)); int G = gridDim.x; asm volatile("" : "+s"(G)); const int ngw = G * 8; (void)ngw; const int lane = tid & 63, wave = __builtin_amdgcn_readfirstlane(tid >> 6), gw = bid * 8 + wave; (void)lane; (void)gw; \
    int zo_ = 0; asm volatile("" : "+s"(zo_)); const KPTR* kin = (const KPTR*)__builtin_amdgcn_kernarg_segment_ptr() + zo_; unsigned char* ws = (unsigned char*)kin[38]; float* dout = (float*)kin[37]; (void)ws; (void)dout;
#define PHASE_END   if (ph + 1 < a.ph_hi || rep_ < (int)((PROBE_DUP >> ph) & 1u)) { XcdBarrier xb_; xb_.bar = (unsigned*)(ws + WS_CTL) + CTL_BAR_WORD; xb_.x = xb_xcc_id(); xb_.st = (volatile LAS unsigned*)(L + LDS_BST); xcd_barrier(xb_); } else __syncthreads(); } ++ph;

#define CVT(src, K_, N_, dst, Nout_, mode_) cvt_job(IN(src), K_, N_, (bf16_t*)(ws + (dst)), Nout_, mode_, (LAS float*)(L + wave * 16384), gw, ngw, lane)

#define normmod(zin, has_ln, lng_, lnb_, mods_, ksh, ksc) normmod_f(zin, has_ln, lng_, lnb_, mods_, ksh, ksc, PST, MUR, HMOD, gw, ngw, lane)
#define gemm_ffin() do { pg8::Gemm g{HMOD, FFIN, MT, 2 * DFF, DM, DM, DM}; pg8::StaticOrder S; S.init(MT, 2 * DFF, G, bid); pg8::EpiSwiGLU E{ACT, DFF}; pg8::gemm_phase(L, g, S, E); } while (0)
#define gemm_resid(A_, K_, Wt_, zprev_, has_ln_, lng_, lnb_, gate_, scale_, zout_) do { pg8::Gemm g{A_, Wt_, MT, DM, K_, K_, K_}; pg8::StaticOrder S; S.init(MT, DM, G, bid); \
        pg8::EpiResid<(scale_) < 0.75f> E{zprev_, (has_ln_) ? MUR : nullptr, lng_, lnb_, gate_, zout_, PST}; pg8::gemm_phase(L, g, S, E); } while (0)

template <int layer>
DI void layer_body(const KArgs& a, LAS unsigned char* L, int& ph, cg::grid_group& grid) {
        const int IL = layer ? I_L1 : I_L0;
#define mods_l (MODS + (size_t)layer * 8 * 9216)
#define lng IN(IL + 2)
#define lnb IN(IL + 3)
#define lngp (IN(I_L0 + 2) + 2 * DM)
#define lnbp (IN(I_L0 + 3) + 2 * DM)
#define zin0 (layer ? (const float*)ZA : (const float*)IN(I_X))
#define bufA (layer ? dout : ZA)
#define bufB (layer ? ZA : dout)
        PHASE_BEGIN
            normmod(zin0, layer == 1, lngp, lnbp, mods_l, 0, 1);
            if (layer == 1) {
                CVT(I_L1 + 4, DM, 2 * DFF, WS_FFIN, 2 * DFF, 1);
                CVT(I_L1 + 5, DFF, DM, WS_FFOUT, DM, 0);
                CVT(I_WUV, DM, 4096, WS_WUV1, 4096, 0);
                CVT(I_WOUT1, 2048, DM, WS_WOUT1, DM, 0);
                {
                    for (int i = bid * 512 + tid; i < 16 * 128 * 128 / 4; i += G * 512) { const int e = i * 4, t = (e >> 7) & 127, s0 = e & 127;
                        const f32x4 v = *(const f32x4*)(IN(I_WS) + e);
                        *(u32x2*)(((bf16_t*)(ws + WS_WSB)) + e) = (u32x2){pk2(s0 <= t ? v[0] : 0.f, s0 + 1 <= t ? v[1] : 0.f), pk2(s0 + 2 <= t ? v[2] : 0.f, s0 + 3 <= t ? v[3] : 0.f)}; }
                }
            }
        PHASE_END
        PHASE_BEGIN gemm_ffin(); PHASE_END
        PHASE_BEGIN gemm_resid(ACT, DFF, FFOUT, zin0, layer == 1, lngp, lnbp, mods_l + 2 * DM, 0.5f, bufA); PHASE_END
        PHASE_BEGIN
            normmod(bufA, true, lng, lnb, mods_l, 3, 4);
            CVT(IL + 6, DM, 2 * DFF, WS_FFIN, 2 * DFF, 1);
            CVT(IL + 7, DFF, DM, WS_FFOUT, DM, 0);
        PHASE_END
        if (layer == 0) {
#define ZG ((bf16_t*)(ws + WS_ZG))
#define PROJ2 ((bf16_t*)(ws + WS_PROJ2))
#define XT ((bf16_t*)(ws + WS_XT))
#define BT ((bf16_t*)(ws + WS_BT))
#define BN ((bf16_t*)(ws + WS_BN))
#define CN ((bf16_t*)(ws + WS_CN))
#define DT ((float*)(ws + WS_DT))
#define CS ((float*)(ws + WS_CS))
#define CKVN ((bf16_t*)(ws + WS_CKVN))
#define YCAT ((bf16_t*)(ws + WS_YCAT))
#define KN ((bf16_t*)(ws + WS_KN))
#define VT ((bf16_t*)(ws + WS_VT))
#define Q ((bf16_t*)((char*)dout + DO_Q))
#define CQN ((bf16_t*)((char*)dout + DO_CQN))
#define KPE ((bf16_t*)((char*)dout + DO_KPE))
#define SSQ ((float*)((char*)dout + DO_SSQ))
            PHASE_BEGIN
                pg8::Gemm g{HMOD, (bf16_t*)(ws + WS_WIN), MT, 3328, DM, DM, DM}; pg8::StaticOrder S; S.init(MT, 3328, G, bid);
                pg8::EpiBf16 E{ZG, 1024, PROJ2, 2304, 4}; pg8::gemm_phase(L, g, S, E);
            PHASE_END
            PHASE_BEGIN
                {
                    LAS bf16_t* tin = (LAS bf16_t*)L;
                    for (int u = bid; u < 128 * 24; u += G) {
                        const int tb = u / 24, cb = u % 24, t0 = tb * 128, c0 = cb * 64;
                        __syncthreads();
                        for (int i = tid; i < 131 * 8; i += 512) { const int rr = i >> 3, ch8 = (i & 7) * 8; const int tok = t0 - 3 + rr;
                            u32x4 v = (u32x4){0u, 0u, 0u, 0u};
                            if (!((t0 & (SEQ - 1)) == 0 && rr < 3)) v = *(const u32x4*)(PROJ2 + (size_t)tok * 2304 + c0 + ch8);
                            *(LAS u32x4*)(tin + rr * 64 + ch8) = v; }
                        __syncthreads();
                        const int ch = tid & 63, seg = tid >> 6, cg_ = c0 + ch;
                        const float w0 = IN(I_CONVW)[cg_], w1 = IN(I_CONVW)[1536 + cg_], w2 = IN(I_CONVW)[2 * 1536 + cg_], w3 = IN(I_CONVW)[3 * 1536 + cg_], cbias = IN(I_CONVB)[cg_];
                        float iv[19];
#pragma unroll
                        for (int i = 0; i < 19; ++i) iv[i] = bf1(tin[(seg * 16 + i) * 64 + ch]);
                        float o[16];
#pragma unroll
                        for (int i = 0; i < 16; ++i) o[i] = silu_f(cbias + w0 * iv[i] + w1 * iv[i + 1] + w2 * iv[i + 2] + w3 * iv[i + 3]);
                        const int bb = t0 / SEQ, s0 = (t0 & (SEQ - 1)) + seg * 16;
                        u32x4 p0, p1; p0.x = pk2(o[0], o[1]); p0.y = pk2(o[2], o[3]); p0.z = pk2(o[4], o[5]); p0.w = pk2(o[6], o[7]);
                        p1.x = pk2(o[8], o[9]); p1.y = pk2(o[10], o[11]); p1.z = pk2(o[12], o[13]); p1.w = pk2(o[14], o[15]);
                        if (cg_ < 1024) { bf16_t* d = XT + ((size_t)bb * 1024 + cg_) * SEQ + s0; *(u32x4*)d = p0; *(u32x4*)(d + 8) = p1; }
                        else if (cg_ < 1280) { const int n = cg_ - 1024; bf16_t* d = BT + ((size_t)bb * 256 + n) * SEQ + s0; *(u32x4*)d = p0; *(u32x4*)(d + 8) = p1;
#pragma unroll
                            for (int i = 0; i < 16; ++i) BN[(size_t)(t0 + seg * 16 + i) * 256 + n] = tobf(o[i]); }
                        else { const int n = cg_ - 1280;
#pragma unroll
                            for (int i = 0; i < 16; ++i) CN[(size_t)(t0 + seg * 16 + i) * 256 + n] = tobf(o[i]); }
                    }
                    __syncthreads();
                }
                {
                    LAS float* dtl = (LAS float*)(L + 32768);
                    for (int u = bid; u < 128; u += G) {
                        __syncthreads();
                        for (int i = tid; i < 2048; i += 512) { const int tk = i >> 4, h = i & 15;
                            const float x = bf1(PROJ2[(size_t)(u * 128 + tk) * 2304 + 1536 + h]) + IN(I_DTB)[h];
                            dtl[i] = fmaxf(x, 0.f) + log1pf(__expf(-fabsf(x))); }
                        __syncthreads();
                        if (tid < 16) { const int h = tid, bb = u >> 4, s0 = (u & 15) * 128; const float av = -__expf(IN(I_ALOG)[h]); float cs = 0.f;
                            float* dp = DT + ((size_t)bb * 16 + h) * SEQ + s0; float* cp = CS + ((size_t)bb * 16 + h) * SEQ + s0;
                            for (int t = 0; t < 128; ++t) { const float d = dtl[t * 16 + h]; cs += d * av; dp[t] = d; cp[t] = cs; } }
                    }
                    __syncthreads();
                }
                for (int m = gw; m < MT; m += ngw) {
                    const bf16_t* pr = PROJ2 + (size_t)m * 2304;
                    float x[6]; float s = 0.f;
#pragma unroll
                    for (int j = 0; j < 3; ++j) { const unsigned v = *(const unsigned*)(pr + 1552 + 2 * lane + 128 * j); x[2 * j] = bflo(v); x[2 * j + 1] = bfhi(v); s += x[2 * j] * x[2 * j] + x[2 * j + 1] * x[2 * j + 1]; }
                    float rs = rsqrtf(wave_sum(s, lane) * (1.f / 384.f) + LN_EPS);
#pragma unroll
                    for (int j = 0; j < 3; ++j) { const int e = 2 * lane + 128 * j; *(unsigned*)(CQN + (size_t)m * 384 + e) = pk2(x[2 * j] * rs * IN(I_QNW)[e], x[2 * j + 1] * rs * IN(I_QNW)[e + 1]); }
                    const u32x2 kv = *(const u32x2*)(pr + 1936 + 4 * lane);
                    const float k0 = bflo(kv.x), k1 = bfhi(kv.x), k2 = bflo(kv.y), k3 = bfhi(kv.y);
                    rs = rsqrtf(wave_sum(k0 * k0 + k1 * k1 + k2 * k2 + k3 * k3, lane) * (1.f / 256.f) + LN_EPS);
                    const f32x4 kw = *(const f32x4*)(IN(I_KVNW) + 4 * lane);
                    *(u32x2*)(CKVN + (size_t)m * 256 + 4 * lane) = (u32x2){pk2(k0 * rs * kw[0], k1 * rs * kw[1]), pk2(k2 * rs * kw[2], k3 * rs * kw[3])};
                    if (lane < 32) { const int pos = m & (SEQ - 1); const float x1 = bf1(pr[2192 + lane]), x2 = bf1(pr[2192 + 32 + lane]);
                        const float c = ROPEC[pos * 32 + lane], sn = ROPES[pos * 32 + lane];
                        KPE[(size_t)m * 64 + lane] = tobf(x1 * c - x2 * sn); KPE[(size_t)m * 64 + 32 + lane] = tobf(x2 * c + x1 * sn); }
                }
            PHASE_END
            PHASE_BEGIN
                { pg8::Gemm g{CQN, (bf16_t*)(ws + WS_WUQ), MT, 1536, 384, 384, 384}; pg8::StaticOrder S; S.init(MT, 1536, G, bid);
                  pg8::EpiQRope E{Q, ROPEC, ROPES}; pg8::gemm_phase(L, g, S, E); }
                { pg8::Gemm g{CKVN, (bf16_t*)(ws + WS_WUK), MT, 1024, 256, 256, 256}; pg8::StaticOrder S; S.init(MT, 1024, G, bid);
                  pg8::EpiBf16 E{KN, 1024, KN, 1024, 0}; pg8::gemm_phase(L, g, S, E); }
                { pg8::Gemm g{(bf16_t*)(ws + WS_WUV0), CKVN, 1024, MT, 256, 256, 256}; pg8::StaticOrder S; S.init(1024, MT, G, bid);
                  pg8::EpiBf16 E{VT, MT, VT, MT, 0}; pg8::gemm_phase(L, g, S, E); }
            PHASE_END
            PHASE_BEGIN
                const int r = lane & 31, hh = lane >> 5;
#ifndef NO_SSD
                if (bid < 128) {
                    constexpr int BL = 0, CL = 34816, WL = 69632, XL = 104448, SL = 121856, DTL = 139264, CSL = 139776, RS = 272;
                    const int b = bid >> 4, hd = bid & 15, g = hd >> 3, pb = wave >> 2, qb = wave & 3;
                    const float dskip = IN(I_DSKIP)[hd];
                    const float* dtp = DT + ((size_t)b * 16 + hd) * SEQ; const float* csp = CS + ((size_t)b * 16 + hd) * SEQ;
                    f32x16 st = zero16();
                    for (int c = 0; c < 16; ++c) {
                        const int t0 = c * 128; const size_t tokb = (size_t)b * SEQ + t0;
                        __syncthreads();
                        if (tid < 128) ((LAS float*)(L + DTL))[tid] = dtp[t0 + tid];
                        else if (tid < 256) ((LAS float*)(L + CSL))[tid - 128] = csp[t0 + tid - 128];
                        const float cse = csp[t0 + 127];
#pragma unroll
                        for (int i = 0; i < 4; ++i) { const int ci = tid + 512 * i, row = ci >> 4, ch = ci & 15;
                            *(LAS u32x4*)(L + BL + row * RS + ch * 16) = *(const u32x4*)(BN + (tokb + row) * 256 + g * 128 + ch * 8);
                            *(LAS u32x4*)(L + CL + row * RS + ch * 16) = *(const u32x4*)(CN + (tokb + row) * 256 + g * 128 + ch * 8);
                            const u32x4 bt = *(const u32x4*)(BT + ((size_t)b * 256 + g * 128 + row) * SEQ + t0 + ch * 8);
                            const f32x4 d0 = *(const f32x4*)(dtp + t0 + ch * 8), d1 = *(const f32x4*)(dtp + t0 + ch * 8 + 4);
                            const f32x4 c0 = *(const f32x4*)(csp + t0 + ch * 8), c1 = *(const f32x4*)(csp + t0 + ch * 8 + 4);
                            u32x4 o;
                            o.x = pk2(bflo(bt.x) * d0[0] * __expf(cse - c0[0]), bfhi(bt.x) * d0[1] * __expf(cse - c0[1]));
                            o.y = pk2(bflo(bt.y) * d0[2] * __expf(cse - c0[2]), bfhi(bt.y) * d0[3] * __expf(cse - c0[3]));
                            o.z = pk2(bflo(bt.z) * d1[0] * __expf(cse - c1[0]), bfhi(bt.z) * d1[1] * __expf(cse - c1[1]));
                            o.w = pk2(bflo(bt.w) * d1[2] * __expf(cse - c1[2]), bfhi(bt.w) * d1[3] * __expf(cse - c1[3]));
                            *(LAS u32x4*)(L + WL + row * RS + ch * 16) = o; }
#pragma unroll
                        for (int i = 0; i < 2; ++i) { const int ci = tid + 512 * i, p = ci >> 4, ch = ci & 15;
                            *(LAS u32x4*)(L + XL + p * RS + ch * 16) = *(const u32x4*)(XT + ((size_t)b * 1024 + hd * 64 + p) * SEQ + t0 + ch * 8); }
#pragma unroll
                        for (int i = 0; i < 16; ++i) *(LAS bf16_t*)(L + SL + (32 * pb + crow(i, hh)) * RS + (32 * qb + r) * 2) = tobf(st[i]);
                        __syncthreads();
                        const LAS float* dtl = (const LAS float*)(L + DTL); const LAS float* csl = (const LAS float*)(L + CSL);
                        const int lb = qb, l = 32 * lb + r; const float csL = csl[l];
                        f32x16 y = zero16();
#pragma unroll
                        for (int ks = 0; ks < 8; ++ks) y = mfma32(*(const LAS bf16x8*)(L + SL + (32 * pb + r) * RS + (16 * ks + 8 * hh) * 2), *(const LAS bf16x8*)(L + CL + l * RS + (16 * ks + 8 * hh) * 2), y);
                        { const float e = __expf(csL);
#pragma unroll
                          for (int i = 0; i < 16; ++i) y[i] *= e; }
                        for (int sb = 0; sb <= lb; ++sb) {
                            f32x16 cb = zero16();
#pragma unroll
                            for (int ks = 0; ks < 8; ++ks) cb = mfma32(*(const LAS bf16x8*)(L + BL + (32 * sb + r) * RS + (16 * ks + 8 * hh) * 2), *(const LAS bf16x8*)(L + CL + l * RS + (16 * ks + 8 * hh) * 2), cb);
#pragma unroll
                            for (int i = 0; i < 16; ++i) { const int s = 32 * sb + crow(i, hh); cb[i] = (s <= l) ? cb[i] * __expf(csL - csl[s]) * dtl[s] : 0.f; }
#pragma unroll
                            for (int s2 = 0; s2 < 2; ++s2) {
                                u32x4 pf; pf.x = pk2(cb[8 * s2], cb[8 * s2 + 1]); pf.y = pk2(cb[8 * s2 + 2], cb[8 * s2 + 3]); pf.z = pk2(cb[8 * s2 + 4], cb[8 * s2 + 5]); pf.w = pk2(cb[8 * s2 + 6], cb[8 * s2 + 7]);
                                const LAS unsigned char* xp = L + XL + (32 * pb + r) * RS + (32 * sb + 16 * s2 + 4 * hh) * 2;
                                const u32x2 x0 = *(const LAS u32x2*)xp, x1 = *(const LAS u32x2*)(xp + 16);
                                const u32x4 xa = (u32x4){x0.x, x0.y, x1.x, x1.y};
                                y = mfma32(__builtin_bit_cast(bf16x8, xa), __builtin_bit_cast(bf16x8, pf), y); }
                        }
                        { float ssq = 0.f; const size_t tok = tokb + l;
#pragma unroll
                          for (int q4 = 0; q4 < 4; ++q4) { const int p0 = 32 * pb + 8 * q4 + 4 * hh;
                              const u32x2 zz = *(const u32x2*)(ZG + tok * 1024 + hd * 64 + p0);
                              const float zf[4] = {bflo(zz.x), bfhi(zz.x), bflo(zz.y), bfhi(zz.y)}; float o[4];
#pragma unroll
                              for (int j = 0; j < 4; ++j) { const float xv = bf1(*(const LAS bf16_t*)(L + XL + (p0 + j) * RS + l * 2));
                                  o[j] = (y[4 * q4 + j] + dskip * xv) * silu_f(zf[j]); ssq += o[j] * o[j]; }
                              *(u32x2*)(YCAT + tok * 2048 + hd * 64 + p0) = (u32x2){pk2(o[0], o[1]), pk2(o[2], o[3])}; }
                          ssq += shx(ssq, 32, lane);
                          if (hh == 0) SSQ[tok * 32 + hd * 2 + pb] = ssq; }
                        { const float dec = __expf(cse);
#pragma unroll
                          for (int i = 0; i < 16; ++i) st[i] *= dec;
#pragma unroll
                          for (int ks = 0; ks < 8; ++ks) st = mfma32(*(const LAS bf16x8*)(L + XL + (32 * pb + r) * RS + (16 * ks + 8 * hh) * 2), *(const LAS bf16x8*)(L + WL + (32 * qb + r) * RS + (16 * ks + 8 * hh) * 2), st); }
                    }
                }
#endif
#ifndef NO_ATT
                {
                    constexpr int KL = 0, KRS = 400, VL = 25600, VRS = 144, UW = 147000;
                    unsigned* ctr = (unsigned*)(ws + WS_CTL) + 64 * rep_;
                    for (;;) {
                        __syncthreads();
                        if (tid == 0) *(LAS unsigned*)(L + UW) = atomicAdd(ctr, 1u);
                        __syncthreads();
                        const unsigned u = *(LAS unsigned*)(L + UW);
                        if (u >= 512u) break;
                        const int j = 7 - (int)(u >> 6), bh = (int)(u & 63), b = bh >> 3, h = bh & 7;
                        const int q0 = 256 * j, qw = q0 + 32 * wave, nt = 4 * j + 4, ktmax = 4 * j + (wave >> 1);
                        const size_t tb = (size_t)b * SEQ;
                        bf16x8 qf[12];
#pragma unroll
                        for (int ks = 0; ks < 12; ++ks) qf[ks] = *(const bf16x8*)(Q + (tb + qw + r) * 1536 + h * 192 + 16 * ks + 8 * hh);
                        f32x16 o[4]; o[0] = zero16(); o[1] = zero16(); o[2] = zero16(); o[3] = zero16();
                        float mrun = -1e30f, lrun = 0.f;
                        u32x4 kreg[3], vreg[2];
#define ldtile(kt_) do { const int k0 = 64 * (kt_); \
                            _Pragma("unroll") for (int i = 0; i < 3; ++i) { const int ci = tid + 512 * i, key = ci / 24, cc = ci % 24; \
                                kreg[i] = cc < 16 ? *(const u32x4*)(KN + (tb + k0 + key) * 1024 + h * 128 + cc * 8) : *(const u32x4*)(KPE + (tb + k0 + key) * 64 + (cc - 16) * 8); } \
                            _Pragma("unroll") for (int i = 0; i < 2; ++i) { const int ci = tid + 512 * i, d = ci >> 3, g8 = ci & 7; \
                                vreg[i] = *(const u32x4*)(VT + ((size_t)h * 128 + d) * MT + tb + k0 + g8 * 8); } } while (0)
                        ldtile(0);
                        for (int kt = 0; kt < nt; ++kt) {
                            __syncthreads();
#pragma unroll
                            for (int i = 0; i < 3; ++i) { const int ci = tid + 512 * i, key = ci / 24, cc = ci % 24; *(LAS u32x4*)(L + KL + key * KRS + cc * 16) = kreg[i]; }
#pragma unroll
                            for (int i = 0; i < 2; ++i) { const int ci = tid + 512 * i, d = ci >> 3, g8 = ci & 7; const int pos = 32 * (g8 >> 2) + 16 * ((g8 >> 1) & 1) + 4 * (g8 & 1);
                                *(LAS u32x2*)(L + VL + d * VRS + pos * 2) = (u32x2){vreg[i].x, vreg[i].y};
                                *(LAS u32x2*)(L + VL + d * VRS + (pos + 8) * 2) = (u32x2){vreg[i].z, vreg[i].w}; }
                            __syncthreads();
                            if (kt + 1 < nt) ldtile(kt + 1);
                            if (kt <= ktmax) {
                                f32x16 s0 = zero16(), s1 = zero16();
#pragma unroll
                                for (int ks = 0; ks < 12; ++ks) {
                                    s0 = mfma32(*(const LAS bf16x8*)(L + KL + r * KRS + (16 * ks + 8 * hh) * 2), qf[ks], s0);
                                    s1 = mfma32(*(const LAS bf16x8*)(L + KL + (32 + r) * KRS + (16 * ks + 8 * hh) * 2), qf[ks], s1); }
                                if (kt == ktmax) { const int qp = qw + r, kb0 = 64 * kt;
#pragma unroll
                                    for (int i = 0; i < 16; ++i) { if (kb0 + crow(i, hh) > qp) s0[i] = -1e30f; if (kb0 + 32 + crow(i, hh) > qp) s1[i] = -1e30f; } }
                                float mx = -1e30f;
#pragma unroll
                                for (int i = 0; i < 16; ++i) mx = fmaxf(mx, fmaxf(s0[i], s1[i]));
                                mx = fmaxf(mx, shx(mx, 32, lane));
                                const float mnew = fmaxf(mrun, mx), al = __builtin_amdgcn_exp2f(mrun - mnew);
                                float rsum = 0.f;
#pragma unroll
                                for (int i = 0; i < 16; ++i) { s0[i] = __builtin_amdgcn_exp2f(s0[i] - mnew); s1[i] = __builtin_amdgcn_exp2f(s1[i] - mnew); rsum += s0[i] + s1[i]; }
                                rsum += shx(rsum, 32, lane);
                                lrun = lrun * al + rsum; mrun = mnew;
#pragma unroll
                                for (int db = 0; db < 4; ++db)
#pragma unroll
                                    for (int i = 0; i < 16; ++i) o[db][i] *= al;
#pragma unroll
                                for (int kb = 0; kb < 2; ++kb)
#pragma unroll
                                    for (int s2 = 0; s2 < 2; ++s2) { const f32x16& sv = kb ? s1 : s0;
                                        u32x4 pf; pf.x = pk2(sv[8 * s2], sv[8 * s2 + 1]); pf.y = pk2(sv[8 * s2 + 2], sv[8 * s2 + 3]); pf.z = pk2(sv[8 * s2 + 4], sv[8 * s2 + 5]); pf.w = pk2(sv[8 * s2 + 6], sv[8 * s2 + 7]);
#pragma unroll
                                        for (int db = 0; db < 4; ++db)
                                            o[db] = mfma32(*(const LAS bf16x8*)(L + VL + (32 * db + r) * VRS + (32 * kb + 16 * s2 + 8 * hh) * 2), __builtin_bit_cast(bf16x8, pf), o[db]); }
                            }
                        }
                        const float inv = 1.0f / lrun;
#pragma unroll
                        for (int db = 0; db < 4; ++db)
#pragma unroll
                            for (int q4 = 0; q4 < 4; ++q4) { const int d0 = 32 * db + 8 * q4 + 4 * hh;
                                *(u32x2*)(YCAT + (tb + qw + r) * 2048 + 1024 + h * 128 + d0) = (u32x2){pk2(o[db][4 * q4] * inv, o[db][4 * q4 + 1] * inv), pk2(o[db][4 * q4 + 2] * inv, o[db][4 * q4 + 3] * inv)}; }
                    }
                }
#endif
            PHASE_END
            PHASE_BEGIN
                for (int m0 = gw * 4; m0 < MT; m0 += ngw * 4) {
                    float sq[4]; u32x2 v[4][4];
#pragma unroll
                    for (int r = 0; r < 4; ++r) sq[r] = (lane < 32) ? SSQ[(size_t)(m0 + r) * 32 + lane] : 0.f;
#pragma unroll
                    for (int r = 0; r < 4; ++r)
#pragma unroll
                        for (int j = 0; j < 4; ++j) v[r][j] = *(const u32x2*)(YCAT + (size_t)(m0 + r) * 2048 + 4 * lane + 256 * j);
                    float r0[4], r1[4];
#pragma unroll
                    for (int r = 0; r < 4; ++r) { float s = sq[r];
                        s += shx(s, 1, lane); s += shx(s, 2, lane); s += shx(s, 4, lane); s += shx(s, 8, lane);
                        r0[r] = rsqrtf(rdl(s, 0) * (1.f / 512.f) + LN_EPS); r1[r] = rsqrtf(rdl(s, 16) * (1.f / 512.f) + LN_EPS); }
#pragma unroll
                    for (int j = 0; j < 4; ++j) { const int col = 4 * lane + 256 * j; const f32x4 w = *(const f32x4*)(IN(I_SSDNW) + col);
#pragma unroll
                        for (int r = 0; r < 4; ++r) { const float rr = col < 512 ? r0[r] : r1[r];
                            *(u32x2*)(YCAT + (size_t)(m0 + r) * 2048 + col) = (u32x2){pk2(bflo(v[r][j].x) * rr * w[0], bfhi(v[r][j].x) * rr * w[1]), pk2(bflo(v[r][j].y) * rr * w[2], bfhi(v[r][j].y) * rr * w[3])}; } }
                }
            PHASE_END
            PHASE_BEGIN gemm_resid(YCAT, 2048, (bf16_t*)(ws + WS_WOUT0), ZA, true, lng, lnb, mods_l + 5 * DM, 1.0f, dout); PHASE_END
        } else {
#define UV ((bf16_t*)(ws + WS_UV))
#define VST ((float*)(ws + WS_VST))
#define WSB ((bf16_t*)(ws + WS_WSB))
            PHASE_BEGIN
                pg8::Gemm g{HMOD, (bf16_t*)(ws + WS_WUV1), MT, 4096, DM, DM, DM}; pg8::StaticOrder S; S.init(MT, 4096, G, bid);
                pg8::EpiGeluUV E{UV, IN(I_BUV), VST}; pg8::gemm_phase(L, g, S, E);
            PHASE_END
            PHASE_BEGIN
                constexpr int WLo = 0, VLo = 34816, MRL = 69632, RS = 272;
                const int r = lane & 31, hh = lane >> 5, tbk = wave & 3, dh = wave >> 2;
                for (int u = bid; u < 2048; u += G) {
                    const int g = u & 15, bc = u >> 4; const size_t tok0 = (size_t)bc * 128;
                    __syncthreads();
                    if (tid < 128) { float s = 0.f, q = 0.f; const float* vp = VST + (tok0 + tid) * 64;
#pragma unroll
                        for (int i = 0; i < 16; ++i) { const f32x4 v = *(const f32x4*)(vp + 4 * i); s += v[0] + v[2]; q += v[1] + v[3]; }
                        const float mu = s * (1.f / 2048.f), rs = rsqrtf(fmaxf(q * (1.f / 2048.f) - mu * mu, 0.f) + LN_EPS);
                        *(LAS f32x2*)(L + MRL + tid * 8) = (f32x2){mu, rs}; }
#pragma unroll
                    for (int i = 0; i < 4; ++i) { const int ci = tid + 512 * i, row = ci >> 4, ch = ci & 15;
                        *(LAS u32x4*)(L + WLo + row * RS + ch * 16) = *(const u32x4*)(WSB + ((size_t)g * 128 + row) * 128 + ch * 8); }
                    __syncthreads();
#pragma unroll
                    for (int i = 0; i < 4; ++i) { const int ci = tid + 512 * i, s = ci >> 4, dc = ci & 15, d0 = dc * 8;
                        const u32x4 v = *(const u32x4*)(UV + (tok0 + s) * 4096 + 2048 + g * 128 + d0);
                        const f32x2 mr = *(const LAS f32x2*)(L + MRL + s * 8);
                        const f32x4 g0 = *(const f32x4*)(IN(I_SLNG) + g * 128 + d0), g1 = *(const f32x4*)(IN(I_SLNG) + g * 128 + d0 + 4);
                        const f32x4 b0 = *(const f32x4*)(IN(I_SLNB) + g * 128 + d0), b1 = *(const f32x4*)(IN(I_SLNB) + g * 128 + d0 + 4);
                        const float vv[8] = {bflo(v.x), bfhi(v.x), bflo(v.y), bfhi(v.y), bflo(v.z), bfhi(v.z), bflo(v.w), bfhi(v.w)};
#pragma unroll
                        for (int e = 0; e < 8; ++e) { const float gg = e < 4 ? g0[e & 3] : g1[e & 3], bb = e < 4 ? b0[e & 3] : b1[e & 3];
                            *(LAS bf16_t*)(L + VLo + (d0 + e) * RS + s * 2) = tobf((vv[e] - mr.x) * mr.y * gg + bb); } }
                    __syncthreads();
                    f32x16 acc0 = zero16(), acc1 = zero16();
                    const int t = 32 * tbk + r;
                    for (int ks = 0; ks < 2 * (tbk + 1); ++ks) { const bf16x8 wf = *(const LAS bf16x8*)(L + WLo + t * RS + (16 * ks + 8 * hh) * 2);
                        acc0 = mfma32(*(const LAS bf16x8*)(L + VLo + (64 * dh + r) * RS + (16 * ks + 8 * hh) * 2), wf, acc0);
                        acc1 = mfma32(*(const LAS bf16x8*)(L + VLo + (64 * dh + 32 + r) * RS + (16 * ks + 8 * hh) * 2), wf, acc1); }
                    const float bs = IN(I_BS)[g * 128 + t];
                    bf16_t* up = UV + (tok0 + t) * 4096 + g * 128;
#pragma unroll
                    for (int db = 0; db < 2; ++db)
#pragma unroll
                        for (int q4 = 0; q4 < 4; ++q4) { const int d0 = 64 * dh + 32 * db + 8 * q4 + 4 * hh; const f32x16& ac = db ? acc1 : acc0;
                            const u32x2 uu = *(const u32x2*)(up + d0);
                            *(u32x2*)(up + d0) = (u32x2){pk2(bflo(uu.x) * (ac[4 * q4] + bs), bfhi(uu.x) * (ac[4 * q4 + 1] + bs)), pk2(bflo(uu.y) * (ac[4 * q4 + 2] + bs), bfhi(uu.y) * (ac[4 * q4 + 3] + bs))}; }
                }
            PHASE_END
            PHASE_BEGIN
                pg8::Gemm g{UV, (bf16_t*)(ws + WS_WOUT1), MT, DM, 2048, 4096, 2048}; pg8::StaticOrder S; S.init(MT, DM, G, bid);
                pg8::EpiResid<false> E{bufA, MUR, lng, lnb, mods_l + 5 * DM, bufB, PST}; pg8::gemm_phase(L, g, S, E);
            PHASE_END
        }
        PHASE_BEGIN normmod(bufB, true, lng + DM, lnb + DM, mods_l, 6, 7); PHASE_END
        PHASE_BEGIN gemm_ffin(); PHASE_END
        PHASE_BEGIN gemm_resid(ACT, DFF, FFOUT, bufB, true, lng + DM, lnb + DM, mods_l + 8 * DM, 0.5f, bufA); PHASE_END
    }

__global__ void __launch_bounds__(512, 2) mega_fwd(KArgs a) {
    extern __shared__ __attribute__((aligned(16))) unsigned char lds_raw[];
    LAS unsigned char* L = (LAS unsigned char*)lds_raw;
    cg::grid_group grid = cg::this_grid();
    if (a.ph_hi < 0) grid.sync();
    { volatile LAS unsigned* bst = (volatile LAS unsigned*)(L + LDS_BST); if (threadIdx.x < 2) bst[threadIdx.x] = 0u; __syncthreads();
      (void)xcd_barrier_post((unsigned*)(a.ws + WS_CTL) + CTL_BAR_WORD, bst); }
    int ph = 0;
    PHASE_BEGIN
        {
            LAS float* sc = (LAS float*)L;
            LAS float* red = (LAS float*)(L + 32768);
            bool loaded = false;
            for (int it = bid; it < 288; it += G) {
                if (!loaded) { for (int i = tid; i < 8192; i += 512) sc[i] = silu_f(IN(I_C)[i]); loaded = true; }
                __syncthreads();
                const int l = it / 144, j0 = (it % 144) * 64, col = tid & 63, kg = tid >> 6;
                const float* W = IN(l ? I_L1 : I_L0) + j0 + col;
                float acc[8];
#pragma unroll
                for (int b = 0; b < 8; ++b) acc[b] = 0.f;
#pragma unroll 8
                for (int k = kg * 128; k < kg * 128 + 128; ++k) { const float w = W[(size_t)k * 9216];
#pragma unroll
                    for (int b = 0; b < 8; ++b) acc[b] += sc[b * 1024 + k] * w; }
#pragma unroll
                for (int b = 0; b < 8; ++b) red[(kg * 8 + b) * 64 + col] = acc[b];
                __syncthreads();
                { const int b = tid >> 6; float s = IN((l ? I_L1 : I_L0) + 1)[j0 + col];
#pragma unroll
                    for (int k8 = 0; k8 < 8; ++k8) s += red[(k8 * 8 + b) * 64 + col];
                    MODS[(size_t)(l * 8 + b) * 9216 + j0 + col] = s; }
            }
            __syncthreads();
        }
        for (int i = bid * 512 + tid; i < SEQ * 32; i += G * 512) { const int pos = i >> 5, f = i & 31;
            const float inv = 1.0f / powf(10000.0f, (float)(2 * f) / 64.0f); const float ang = (float)pos * inv;
            ROPEC[i] = cosf(ang); ROPES[i] = sinf(ang); }
        CVT(I_L0 + 4, DM, 2 * DFF, WS_FFIN, 2 * DFF, 1);
        CVT(I_L0 + 5, DFF, DM, WS_FFOUT, DM, 0);
        CVT(I_WIN, DM, 3280, WS_WIN, 3328, 0);
        CVT(I_WUQ, 384, 1536, WS_WUQ, 1536, 2);
        CVT(I_WUKV, 256, 2048, WS_WUK, 1024, 3);
        CVT(I_WUKV, 256, 2048, WS_WUV0, 1024, 4);
        CVT(I_WOUT0, 2048, DM, WS_WOUT0, DM, 0);
    PHASE_END

    layer_body<0>(a, L, ph, grid);
    layer_body<1>(a, L, ph, grid);
#undef lng
#undef lnb
    PHASE_BEGIN
        const float* lngF = IN(I_L1 + 2) + 2 * DM; const float* lnbF = IN(I_L1 + 3) + 2 * DM;
        for (int m0 = gw * 4; m0 < MT; m0 += ngw * 4) {
            f32x4 x[4][4]; f32x2 p[4]; float mu[4], rs[4];
#pragma unroll
            for (int r = 0; r < 4; ++r) { p[r] = (f32x2){0.f, 0.f}; if (lane < 16) p[r] = *(const f32x2*)(PST + (size_t)(m0 + r) * 32 + lane * 2); }
#pragma unroll
            for (int r = 0; r < 4; ++r)
#pragma unroll
                for (int j = 0; j < 4; ++j) x[r][j] = *(const f32x4*)(dout + (size_t)(m0 + r) * DM + 4 * lane + 256 * j);
#pragma unroll
            for (int r = 0; r < 4; ++r) { float s = p[r].x, q = p[r].y;
#pragma unroll
                for (int o = 1; o < 16; o <<= 1) { s += shx(s, o, lane); q += shx(q, o, lane); }
                s = rdl(s, 0); q = rdl(q, 0); mu[r] = s * (1.f / DM); rs[r] = rsqrtf(fmaxf(q * (1.f / DM) - mu[r] * mu[r], 0.f) + LN_EPS); }
#pragma unroll
            for (int j = 0; j < 4; ++j) { const int col = 4 * lane + 256 * j; const f32x4 g4 = *(const f32x4*)(lngF + col), b4 = *(const f32x4*)(lnbF + col);
#pragma unroll
                for (int r = 0; r < 4; ++r) *(f32x4*)(dout + (size_t)(m0 + r) * DM + col) = (x[r][j] - mu[r]) * rs[r] * g4 + b4; }
        }
    PHASE_END
}

constexpr int N_PHASES = 25;

extern "C" void kernel_launch(void* const* d_in, const int* in_sizes, int n_in, void* d_out, int out_size, void* d_ws, size_t ws_size, hipStream_t stream) {
    static int grid = 0;
    if (grid == 0) {
        int dev = 0, cus = 0, per_cu = 0;
        hipGetDevice(&dev); hipDeviceGetAttribute(&cus, hipDeviceAttributeMultiprocessorCount, dev);
        hipFuncSetAttribute((const void*)mega_fwd, hipFuncAttributeMaxDynamicSharedMemorySize, LDS_BYTES);
        hipOccupancyMaxActiveBlocksPerMultiprocessor(&per_cu, (const void*)mega_fwd, 512, LDS_BYTES);
        if (per_cu < 1) { fprintf(stderr, "kernel_launch: occupancy query says %d blocks/CU\n", per_cu); per_cu = 1; }
        grid = cus;
        if (n_in != 37 || ws_size < WS_END) fprintf(stderr, "kernel_launch: unexpected n_in %d / ws_size %zu (need %zu)\n", n_in, ws_size, (size_t)WS_END);
    }
    hipMemsetAsync((char*)d_ws + WS_CTL, 0, 32768, stream);
    KArgs a{};
    for (int i = 0; i < 37; ++i) a.in[i] = (const float*)d_in[i];
    a.out = (float*)d_out; a.ws = (unsigned char*)d_ws;
#if MK_MULTI
    for (int p = 0; p < 25; ++p) { a.ph_lo = p; a.ph_hi = p + 1; hipLaunchKernelGGL(mega_fwd, dim3(grid), dim3(512), LDS_BYTES, stream, a); }
#else
    a.ph_lo = 0; a.ph_hi = N_PHASES;
    void* args[] = {&a};
    hipError_t e = hipLaunchCooperativeKernel((const void*)mega_fwd, dim3(grid), dim3(512), args, LDS_BYTES, stream);
    if (e != hipSuccess) fprintf(stderr, "cooperative launch failed: %s (grid %d)\n", hipGetErrorString(e), grid);
#endif
}
```
